# Optimizing an MI355X kernel written in HIP

```python
import math
import jax, jax.numpy as jnp
from jax import lax
import numpy as np

D_MODEL = 1024
BATCH = 16
SEQ = 4096
DEPTH = 1

CHUNK = 64
Q_BLOCK = 128
SSD_INNER = D_MODEL // 2
SSD_HEAD_DIM = 64
SSD_HEADS = SSD_INNER // SSD_HEAD_DIM
SSD_GROUPS = 2
SSD_STATE = 128
SSD_CONV = 4
SSD_BC = SSD_GROUPS * SSD_STATE
XBC_DIM = SSD_INNER + 2 * SSD_BC
MLA_V = 64
MLA_HEADS = (D_MODEL - SSD_INNER) // MLA_V
MLA_NOPE = 64
MLA_ROPE = 32
Q_LORA = 384
KV_LORA = 256
ROPE_BASE = 10000.0
MIX_WIDTH = SSD_INNER + MLA_HEADS * MLA_V
OFF_Z = 0
OFF_XBC = OFF_Z + SSD_INNER
OFF_DT = OFF_XBC + XBC_DIM
OFF_QA = OFF_DT + SSD_HEADS
OFF_KVA = OFF_QA + Q_LORA
OFF_KR = OFF_KVA + KV_LORA
IN_COLS = OFF_KR + MLA_ROPE
N_EXPERTS = 32
TOP_K = 4
D_FF_EXPERT = 1024
SWIGLU_LIMIT = 7.0
SWIGLU_ALPHA = 1.702
MOE_BLOCK = 256
NORM_EPS = 1e-6
MAX_STREAM_OFFSET = 16384

kernel_name = 'hybrid_ssd_mla_moe_stream_block'


def rms_norm(x, gain):
    xf = x.astype(jnp.float32)
    y = xf * lax.rsqrt(jnp.mean(xf * xf, axis=-1, keepdims=True) + NORM_EPS)
    return (y * gain.astype(jnp.float32)).astype(x.dtype)


def causal_depthwise_conv(x, w, b):
    k = w.shape[0]
    y = lax.conv_general_dilated(x, w[:, None, :], window_strides=(1,), padding=[(k - 1, 0)],
                                 dimension_numbers=('NWC', 'WIO', 'NWC'),
                                 feature_group_count=x.shape[-1])
    return y + b


def apply_rope(x, cos, sin):
    half = x.shape[-1] // 2
    x1, x2 = x[..., :half], x[..., half:]
    return jnp.concatenate([x1 * cos - x2 * sin, x2 * cos + x1 * sin], axis=-1)


def ssd_mixer(z, xbc, dt_raw, conv_w, conv_b, dt_bias, a_log, d_skip, norm_gain):
    f32 = jnp.float32
    bsz, seq, _ = xbc.shape
    nc = seq // CHUNK
    G, R, P, N = SSD_GROUPS, SSD_HEADS // SSD_GROUPS, SSD_HEAD_DIM, SSD_STATE
    xbc = jax.nn.silu(causal_depthwise_conv(xbc, conv_w, conv_b)).astype(f32)
    xs = xbc[..., :SSD_INNER].reshape(bsz, nc, CHUNK, G, R, P)
    bm = xbc[..., SSD_INNER:SSD_INNER + SSD_BC].reshape(bsz, nc, CHUNK, G, N)
    cm = xbc[..., SSD_INNER + SSD_BC:].reshape(bsz, nc, CHUNK, G, N)
    dt = jax.nn.softplus(dt_raw.astype(f32) + dt_bias.astype(f32)).reshape(bsz, nc, CHUNK, G, R)
    a = -jnp.exp(a_log.astype(f32)).reshape(G, R)
    cs = jnp.cumsum(jnp.moveaxis(dt * a, 2, -1), axis=-1)
    xdt = xs * dt[..., None]
    causal = jnp.tril(jnp.ones((CHUNK, CHUNK), dtype=bool))
    seg = cs[..., :, None] - cs[..., None, :]
    decay_in = jnp.exp(jnp.where(causal, seg, -jnp.inf))
    cb = jnp.einsum('bclgn,bcsgn->bcgls', cm, bm)
    y_diag = jnp.einsum('bcgls,bcgrls,bcsgrp->bclgrp', cb, decay_in, xdt)
    decay_to_end = jnp.exp(cs[..., -1:] - cs)
    chunk_states = jnp.einsum('bclgn,bcgrl,bclgrp->bcgrpn', bm, decay_to_end, xdt)
    chunk_decay = jnp.exp(cs[..., -1])

    def carry_state(state, inp):
        new_s, dec = inp
        return dec[..., None, None] * state + new_s, state

    init = jnp.zeros((bsz, G, R, P, N), f32)
    _, prev_states = lax.scan(carry_state, init,
                              (jnp.moveaxis(chunk_states, 1, 0), jnp.moveaxis(chunk_decay, 1, 0)))
    prev_states = jnp.moveaxis(prev_states, 0, 1)
    y_off = jnp.einsum('bclgn,bcgrpn,bcgrl->bclgrp', cm, prev_states, jnp.exp(cs))
    y = y_diag + y_off + xs * d_skip.astype(f32).reshape(G, R, 1)
    y = y.reshape(bsz, seq, SSD_INNER) * jax.nn.silu(z.astype(f32))
    yg = y.reshape(bsz, seq, G, SSD_INNER // G)
    yg = yg * lax.rsqrt(jnp.mean(yg * yg, axis=-1, keepdims=True) + NORM_EPS)
    return (yg.reshape(bsz, seq, SSD_INNER) * norm_gain.astype(f32)).astype(z.dtype)


def mla_mixer(q_a, kv_a, k_rope_raw, cos, sin, q_a_norm, w_q_up, kv_a_norm, w_kv_up, out_norm):
    bsz, seq, _ = q_a.shape
    H = MLA_HEADS
    q = (rms_norm(q_a, q_a_norm) @ w_q_up).reshape(bsz, seq, H, MLA_NOPE + MLA_ROPE)
    q_nope = q[..., :MLA_NOPE]
    q_rope = apply_rope(q[..., MLA_NOPE:], cos[:, :, None, :], sin[:, :, None, :])
    kv = (rms_norm(kv_a, kv_a_norm) @ w_kv_up).reshape(bsz, seq, H, MLA_NOPE + MLA_V)
    k_nope, v = kv[..., :MLA_NOPE], kv[..., MLA_NOPE:]
    k_rope = apply_rope(k_rope_raw, cos, sin)
    scale = 1.0 / math.sqrt(MLA_NOPE + MLA_ROPE)
    outs = []
    for qb in range(seq // Q_BLOCK):
        q0 = qb * Q_BLOCK
        k_end = q0 + Q_BLOCK
        s = (jnp.einsum('bqhd,bkhd->bhqk', q_nope[:, q0:k_end], k_nope[:, :k_end])
             + jnp.einsum('bqhd,bkd->bhqk', q_rope[:, q0:k_end], k_rope[:, :k_end]))
        s = s.astype(jnp.float32) * scale
        q_chunk = (q0 + jnp.arange(Q_BLOCK)) // CHUNK
        k_chunk = jnp.arange(k_end) // CHUNK
        s = jnp.where(k_chunk[None, :] <= q_chunk[:, None], s, -jnp.inf)
        p = jax.nn.softmax(s, axis=-1).astype(v.dtype)
        outs.append(jnp.einsum('bhqk,bkhd->bqhd', p, v[:, :k_end]))
    o = jnp.concatenate(outs, axis=1).reshape(bsz, seq, H * MLA_V)
    return rms_norm(o, out_norm)


def moe_ffn(h, w_router, b_router, w_gate_up, b_gate_up, w_down, b_down):
    n_tok, d = h.shape
    logits = (h @ w_router).astype(jnp.float32) + b_router.astype(jnp.float32)
    top_vals, top_idx = lax.top_k(logits, TOP_K)
    gates = jax.nn.softmax(top_vals, axis=-1)
    n_assign = n_tok * TOP_K
    flat_e = top_idx.reshape(-1).astype(jnp.int32)
    flat_tok = jnp.repeat(jnp.arange(n_tok, dtype=jnp.int32), TOP_K)
    flat_g = gates.reshape(-1)
    order = jnp.argsort(flat_e)
    sorted_e = flat_e[order]
    counts = jnp.bincount(flat_e, length=N_EXPERTS).astype(jnp.int32)
    padded = ((counts + MOE_BLOCK - 1) // MOE_BLOCK) * MOE_BLOCK
    starts = jnp.cumsum(counts) - counts
    padded_end = jnp.cumsum(padded)
    padded_start = padded_end - padded
    rank = jnp.arange(n_assign, dtype=jnp.int32) - starts[sorted_e]
    dest = padded_start[sorted_e] + rank
    n_slots = ((n_assign + MOE_BLOCK - 1) // MOE_BLOCK + N_EXPERTS) * MOE_BLOCK
    n_blocks = n_slots // MOE_BLOCK
    slot_tok = jnp.zeros((n_slots,), jnp.int32).at[dest].set(flat_tok[order])
    slot_gate = jnp.zeros((n_slots,), jnp.float32).at[dest].set(flat_g[order])
    block_start = jnp.arange(n_blocks, dtype=jnp.int32) * MOE_BLOCK
    block_expert = jnp.minimum(jnp.searchsorted(padded_end, block_start, side='right'),
                               N_EXPERTS - 1).astype(jnp.int32)

    def expert_block(args):
        tok, g, e = args
        xb = h[tok]
        gu = xb @ w_gate_up[e] + b_gate_up[e]
        glu = jnp.minimum(gu[:, :D_FF_EXPERT], SWIGLU_LIMIT)
        lin = jnp.clip(gu[:, D_FF_EXPERT:], -SWIGLU_LIMIT, SWIGLU_LIMIT)
        act = glu * jax.nn.sigmoid(SWIGLU_ALPHA * glu) * (lin + 1.0)
        y = act @ w_down[e] + b_down[e]
        return y * g[:, None].astype(y.dtype)

    y = lax.map(expert_block, (slot_tok.reshape(n_blocks, MOE_BLOCK),
                               slot_gate.reshape(n_blocks, MOE_BLOCK), block_expert))
    return jax.ops.segment_sum(y.reshape(n_slots, d), slot_tok, num_segments=n_tok)


def setup_inputs(seed: int = 0) -> dict:
    key = jax.random.key(seed)
    ks = jax.random.split(key, 40)
    f32 = jnp.float32
    nrm = lambda k, shape, s: jax.random.normal(k, shape, f32) * s
    gain = lambda k, shape: 1.0 + 0.05 * jax.random.normal(k, shape, f32)
    L, D, E, F = DEPTH, D_MODEL, N_EXPERTS, D_FF_EXPERT
    x = jax.random.normal(ks[0], (BATCH, SEQ, D), f32)
    c = jax.random.normal(ks[1], (BATCH, D), f32)
    offset = jax.random.randint(ks[2], (BATCH, 1), 0, MAX_STREAM_OFFSET, dtype=jnp.int32)
    positions = offset + jnp.arange(SEQ, dtype=jnp.int32)[None, :]
    dt0 = jnp.exp(jax.random.uniform(ks[9], (L, SSD_HEADS), f32, math.log(1e-3), math.log(1e-1)))
    return {
        'x': x,
        'c': c,
        'positions': positions,
        'w_ada': nrm(ks[3], (L, D, 6 * D), 0.5 * D ** -0.5),
        'b_ada': nrm(ks[4], (L, 6 * D), 0.02),
        'pre_mix_norm': gain(ks[5], (L, D)),
        'w_in': nrm(ks[6], (L, D, IN_COLS), D ** -0.5),
        'conv_w': nrm(ks[7], (L, SSD_CONV, XBC_DIM), SSD_CONV ** -0.5),
        'conv_b': nrm(ks[8], (L, XBC_DIM), 0.02),
        'dt_bias': dt0 + jnp.log(-jnp.expm1(-dt0)),
        'a_log': jnp.log(jax.random.uniform(ks[10], (L, SSD_HEADS), f32, 1.0, 16.0)),
        'd_skip': gain(ks[11], (L, SSD_HEADS)),
        'ssd_norm': gain(ks[12], (L, SSD_INNER)),
        'q_a_norm': gain(ks[13], (L, Q_LORA)),
        'w_q_up': nrm(ks[14], (L, Q_LORA, MLA_HEADS * (MLA_NOPE + MLA_ROPE)), Q_LORA ** -0.5),
        'kv_a_norm': gain(ks[15], (L, KV_LORA)),
        'w_kv_up': nrm(ks[16], (L, KV_LORA, MLA_HEADS * (MLA_NOPE + MLA_V)), KV_LORA ** -0.5),
        'mla_norm': gain(ks[17], (L, MLA_HEADS * MLA_V)),
        'w_out': nrm(ks[18], (L, MIX_WIDTH, D), MIX_WIDTH ** -0.5),
        'post_mix_norm': gain(ks[19], (L, D)),
        'pre_ffn_norm': gain(ks[20], (L, D)),
        'w_router': nrm(ks[21], (L, D, E), D ** -0.5),
        'b_router': nrm(ks[22], (L, E), 0.01),
        'w_gate_up': nrm(ks[23], (L, E, D, 2 * F), D ** -0.5),
        'b_gate_up': nrm(ks[24], (L, E, 2 * F), 0.02),
        'w_down': nrm(ks[25], (L, E, F, D), F ** -0.5),
        'b_down': nrm(ks[26], (L, E, D), 0.02),
        'post_ffn_norm': gain(ks[27], (L, D)),
    }


def reference(x, c, positions, w_ada, b_ada, pre_mix_norm, w_in, conv_w, conv_b, dt_bias, a_log,
              d_skip, ssd_norm, q_a_norm, w_q_up, kv_a_norm, w_kv_up, mla_norm, w_out,
              post_mix_norm, pre_ffn_norm, w_router, b_router, w_gate_up, b_gate_up, w_down,
              b_down, post_ffn_norm):
    bsz, seq, d = x.shape
    inv_freq = ROPE_BASE ** (-(jnp.arange(MLA_ROPE // 2, dtype=jnp.float32) * 2.0 / MLA_ROPE))
    angles = positions.astype(jnp.float32)[..., None] * inv_freq
    cos = jnp.cos(angles).astype(x.dtype)
    sin = jnp.sin(angles).astype(x.dtype)
    c_act = jax.nn.silu(c)
    for l in range(DEPTH):
        mod = c_act @ w_ada[l] + b_ada[l]
        sh1, sc1, g1, sh2, sc2, g2 = jnp.split(mod[:, None, :], 6, axis=-1)
        h = rms_norm(x, pre_mix_norm[l]) * (1.0 + sc1) + sh1
        proj = h @ w_in[l]
        y_ssd = ssd_mixer(proj[..., OFF_Z:OFF_XBC], proj[..., OFF_XBC:OFF_DT], proj[..., OFF_DT:OFF_QA],
                          conv_w[l], conv_b[l], dt_bias[l], a_log[l], d_skip[l], ssd_norm[l])
        y_mla = mla_mixer(proj[..., OFF_QA:OFF_KVA], proj[..., OFF_KVA:OFF_KR], proj[..., OFF_KR:IN_COLS],
                          cos, sin, q_a_norm[l], w_q_up[l], kv_a_norm[l], w_kv_up[l], mla_norm[l])
        mix = jnp.concatenate([y_ssd, y_mla], axis=-1) @ w_out[l]
        x = x + g1 * rms_norm(mix, post_mix_norm[l])
        h = rms_norm(x, pre_ffn_norm[l]) * (1.0 + sc2) + sh2
        f = moe_ffn(h.reshape(bsz * seq, d), w_router[l], b_router[l], w_gate_up[l], b_gate_up[l],
                    w_down[l], b_down[l]).reshape(bsz, seq, d)
        x = x + g2 * rms_norm(f, post_ffn_norm[l])
    return x
```

```cpp
#include <hip/hip_runtime.h>
#include <cstdio>
#include <cstdint>

#ifndef N_LAUNCH_MODE
#define N_LAUNCH_MODE 1
#endif

#define GAS __attribute__((address_space(1)))
#define LAS __attribute__((address_space(3)))
typedef unsigned short bf16_t;
typedef float f32x4 __attribute__((ext_vector_type(4)));
typedef float f32x2 __attribute__((ext_vector_type(2)));
typedef unsigned u32x4 __attribute__((ext_vector_type(4)));
typedef unsigned u32x2 __attribute__((ext_vector_type(2)));
typedef short bf16x8 __attribute__((ext_vector_type(8)));

constexpr int BATCH = 16, SEQ = 4096, DM = 1024, NTOK = BATCH * SEQ;
constexpr int CHUNK = 64, NCHUNK = SEQ / CHUNK;
constexpr int SSD_INNER = 512, SSD_HEADS = 8, SSD_P = 64, SSD_N = 128, XBC_DIM = 1024;
constexpr int MLA_H = 8, Q_LORA = 384, KV_LORA = 256;
constexpr int IN_COLS = 2216, PROJ_LD = 2304;
constexpr int PC_Z = 0, PC_XBC = 512, PC_QA = 1536, PC_KVA = 1920, PC_KR = 2176, PC_DT = 2208;
constexpr int NEXP = 32, TOPK = 4, FF = 1024;
constexpr int NSLOT = (NTOK * TOPK / 256 + NEXP) * 256;
constexpr int ACT_ROWS = NSLOT;
constexpr float NORM_EPS = 1e-6f;
constexpr int NWAVES = 8, NTHR = 512;

constexpr size_t MiB = 1u << 20;
constexpr size_t WS_CTL = 0, CTL_ZERO_BYTES = 1 * MiB;
constexpr size_t WS_MOD = 1 * MiB;
constexpr size_t WS_COS = 2 * MiB, WS_SIN = 6 * MiB;
constexpr size_t WS_DT = 10 * MiB;
constexpr size_t WS_RSTDQ = 12 * MiB, WS_RSTDKV = 12 * MiB + 512 * 1024;
constexpr size_t WS_LOGITS = 13 * MiB;
constexpr size_t WS_TOPE = 21 * MiB, WS_TOPG = 22 * MiB, WS_TOPR = 23 * MiB;
constexpr size_t WS_SLOT_TOK = 24 * MiB, WS_SLOT_Y = 26 * MiB, WS_SLOT_G = 28 * MiB;
constexpr size_t WS_WQ_T = 30 * MiB, WS_WKV_T = 31 * MiB, WS_WR_T = 31 * MiB + 512 * 1024, WS_WOUT_T = 32 * MiB, WS_WIN_T = 34 * MiB;
constexpr size_t WS_PROJ = 40 * MiB;
constexpr size_t WS_XBC = 328 * MiB;
constexpr size_t WS_H1 = 456 * MiB;
constexpr size_t WS_Q = 584 * MiB;
constexpr size_t WS_KK = 680 * MiB;
constexpr size_t WS_V = 744 * MiB;
constexpr size_t WS_YMIX = 808 * MiB;
constexpr size_t WS_KR = 13 * MiB;
constexpr size_t WS_MIX = 40 * MiB;
constexpr size_t WS_ACT = 40 * MiB;
constexpr size_t WS_H2 = 168 * MiB;
constexpr size_t WS_WGU_T = 936 * MiB;
constexpr size_t WS_WDN_T = 368 * MiB;
constexpr size_t WS_H2Q = 400 * MiB;
constexpr size_t WS_X1B = 744 * MiB;
constexpr size_t WS_Y4 = 488 * MiB;
constexpr size_t WS_END = 1000 * MiB;

constexpr int CW_BAR = 4096;
constexpr int CW_CNT = 131072;

constexpr int LDS_BYTES = 163840;
constexpr int MISC_OFF = 135168;

__device__ __forceinline__ float bf2f(bf16_t b) { return __uint_as_float(((unsigned)b) << 16); }
__device__ __forceinline__ unsigned f2bf(float f) { unsigned u = __float_as_uint(f); return (u + 0x7fffu + ((u >> 16) & 1u)) >> 16; }
typedef __bf16 bf16x2_t __attribute__((ext_vector_type(2)));
__device__ __forceinline__ unsigned pk2(float lo, float hi) { const f32x2 v = {lo, hi}; const bf16x2_t b = __builtin_convertvector(v, bf16x2_t); return __builtin_bit_cast(unsigned, b); }
__device__ __forceinline__ float wave_sum(float v) {
#pragma unroll
    for (int o = 1; o < 64; o <<= 1) v += __shfl_xor(v, o);
    return v;
}
__device__ __forceinline__ void st_bf16x4(bf16_t* p, f32x4 v) { u32x2 w; w.x = pk2(v[0], v[1]); w.y = pk2(v[2], v[3]); *(u32x2*)p = w; }
__device__ __forceinline__ f32x4 ld_bf16x4(const bf16_t* p) { const u32x2 w = *(const u32x2*)p; f32x4 r; r[0] = __uint_as_float(w.x << 16); r[1] = __uint_as_float(w.x & 0xffff0000u); r[2] = __uint_as_float(w.y << 16); r[3] = __uint_as_float(w.y & 0xffff0000u); return r; }
__device__ __forceinline__ float clamp_fp8(float v) { return __builtin_amdgcn_fmed3f(v, -448.f, 448.f); }
__device__ __forceinline__ unsigned pk4_fp8(float a, float b, float c, float d) { int w; asm("" : "=v"(w));
    w = __builtin_amdgcn_cvt_pk_fp8_f32(a, b, w, false); w = __builtin_amdgcn_cvt_pk_fp8_f32(c, d, w, true); return (unsigned)w; }
typedef float f32x2v __attribute__((ext_vector_type(2)));
__device__ __forceinline__ f32x4 ld_fp8x4(const unsigned char* p) { const int w = __builtin_nontemporal_load((const int*)p); const f32x2v lo = __builtin_amdgcn_cvt_pk_f32_fp8(w, false), hi = __builtin_amdgcn_cvt_pk_f32_fp8(w, true); return (f32x4){lo[0], lo[1], hi[0], hi[1]}; }
__device__ __forceinline__ float silu_f(float v) { return v / (1.f + __expf(-v)); }

#define XB_TMO      128
#define XB_XCNT(j)  (256  + 64 * (j))
#define XB_XSUB(j)  (1280 + 64 * (j))
#define XB_XGEN(j)  (2304 + 64 * (j))
#define XB_TOP      3328
#define XB_TOPGEN   3392
#define XCD_BAR_WORDS 3456
#define XB_SPIN_CAP (1u << 21)

__device__ __forceinline__ unsigned xb_ld(unsigned* p)              { return __hip_atomic_load(p, __ATOMIC_RELAXED, __HIP_MEMORY_SCOPE_AGENT); }
__device__ __forceinline__ unsigned xb_add(unsigned* p, unsigned v) { return __hip_atomic_fetch_add(p, v, __ATOMIC_RELAXED, __HIP_MEMORY_SCOPE_AGENT); }
__device__ __forceinline__ unsigned xb_xcc_id() { return (unsigned)__builtin_amdgcn_s_getreg((3 << 11) | 20) & 0xFu; }
#define XB_SPIN(cond, bar) do { unsigned _sp = 0; while (cond) { __builtin_amdgcn_s_sleep(1); \
    if ((++_sp & 255u) == 0u) { if (xb_ld(&(bar)[XB_TMO])) break; if (_sp > XB_SPIN_CAP) { atomicAdd(&(bar)[XB_TMO], 1u); break; } } } } while (0)

struct XcdBarrier { unsigned* bar; unsigned x; volatile LAS unsigned* st; };

__device__ __forceinline__ XcdBarrier xcd_barrier_post(unsigned* bar, volatile LAS unsigned* st) {
    XcdBarrier b; b.bar = bar; b.x = xb_xcc_id(); b.st = st;
    if (threadIdx.x == 0) (void)xb_add(&bar[XB_XCNT(b.x)], 1u);
    return b;
}
__device__ __forceinline__ void xcd_barrier_complete(unsigned* bar, unsigned x, unsigned& nloc, unsigned& nx) {
    const unsigned G = gridDim.x * gridDim.y * gridDim.z;
    unsigned sum, cnt, mine, sp = 0u;
    for (;;) {
        sum = 0u; cnt = 0u; mine = 0u;
#pragma unroll
        for (unsigned j = 0; j < 16; ++j) { const unsigned c = xb_ld(&bar[XB_XCNT(j)]); sum += c; cnt += (c > 0u) ? 1u : 0u; mine = (j == x) ? c : mine; }
        if (sum == G) break;
        __builtin_amdgcn_s_sleep(1);
        if ((++sp & 255u) == 0u) { if (xb_ld(&bar[XB_TMO])) break; if (sp > XB_SPIN_CAP) { atomicAdd(&bar[XB_TMO], 1u); break; } }
    }
    nloc = mine > 0u ? mine : 1u; nx = cnt > 0u ? cnt : 1u;
}
__device__ __forceinline__ void xcd_barrier(const XcdBarrier& b) {
    asm volatile("s_waitcnt vmcnt(0)" ::: "memory");
    __syncthreads();
    if (threadIdx.x == 0) {
        unsigned* bar = b.bar;
        __builtin_amdgcn_s_waitcnt(0);
        unsigned nloc = b.st[0], nx = b.st[1];
        if (nloc == 0u) { xcd_barrier_complete(bar, b.x, nloc, nx); b.st[0] = nloc; b.st[1] = nx; }
        const unsigned old = xb_add(&bar[XB_XSUB(b.x)], 1u);
        const unsigned gen = old / nloc;
        if (old + 1u == (gen + 1u) * nloc) {
            __builtin_amdgcn_fence(__ATOMIC_RELEASE, "agent");
            asm volatile("s_waitcnt vmcnt(0)" ::: "memory");
            const unsigned og = xb_add(&bar[XB_TOP], 1u);
            const unsigned tg = og / nx;
            if (og + 1u == (tg + 1u) * nx) xb_add(&bar[XB_TOPGEN], 1u);
            else XB_SPIN(xb_ld(&bar[XB_TOPGEN]) == tg, bar);
            __builtin_amdgcn_fence(__ATOMIC_ACQUIRE, "agent");
            xb_add(&bar[XB_XGEN(b.x)], 1u);
            asm volatile("s_waitcnt vmcnt(0)" ::: "memory");
        } else {
            XB_SPIN(xb_ld(&bar[XB_XGEN(b.x)]) == gen, bar);
            __builtin_amdgcn_fence(__ATOMIC_ACQUIRE, "agent");
            asm volatile("s_waitcnt vmcnt(0)" ::: "memory");
        }
    }
    __syncthreads();
}

struct Args { const void* in[28]; float* out; unsigned char* ws; int ph_lo, ph_hi, li, pad; };

struct Frame {
    LAS unsigned char* lds;
    int tid, lane, wave, G, bid, vcu;
    const Args* a;
};
__device__ __forceinline__ int gtid(const Frame& F) { int t = F.tid; asm volatile("" : "+v"(t)); return F.bid * NTHR + t; }
#define IN_F(i) ((const float*)args.in[i])
#define IN_I(i) ((const int*)args.in[i])

struct Unit { int arow0; int brow0; int pm; int pn; int e; int ui; };
struct Gemm { const bf16_t* A; int lda; const bf16_t* Bt; int K; const int* gather; };

struct DenseOrder {
    int nN, nunits, G, c, owner;
    __device__ __forceinline__ void init(int M, int N, int G_, int c_, int owner_ = 0) { nN = N / 256; nunits = (M / 256) * nN; G = G_; c = c_; owner = owner_; }
    __device__ __forceinline__ bool next(int i, Unit& u) const {
        const int L = owner ? ((i / nN) * G + c) * nN + i % nN : i * G + c; if (L >= nunits) return false;
        u.pm = L / nN; u.pn = L % nN; u.arow0 = u.pm * 256; u.brow0 = u.pn * 256; u.e = 0; u.ui = i; return true;
    }
};
struct MoeOrder {
    int nN, nunits, G, c, p0, e0; const LAS int* pend;
    __device__ __forceinline__ bool next(int i, Unit& u) const {
        const int L = i * G + c; if (L >= nunits) return false;
        const int panel = p0 + L / nN; u.pn = L % nN; u.pm = panel; u.arow0 = panel * 256;
        const int e = pend[32 + panel];
        u.e = e; u.brow0 = (e * nN + u.pn) * 256; u.ui = i; return true;
    }
};

__device__ __forceinline__ void st_bf16x8(bf16_t* p, f32x4 a, f32x4 b) { u32x4 w; w.x = pk2(a[0], a[1]); w.y = pk2(a[2], a[3]); w.z = pk2(b[0], b[1]); w.w = pk2(b[2], b[3]); *(u32x4*)p = w; }
struct EpiStoreBf16 {
    static constexpr int NSTORES = 16; static constexpr bool PERM = true;
    bf16_t* O; int ldc;
    __device__ __forceinline__ void operator()(const f32x4 (&acc)[2][2][4][2], const Unit& u, int wr, int wc, int fr, int fq) const {
#pragma unroll
        for (int ai = 0; ai < 2; ++ai)
#pragma unroll
            for (int m = 0; m < 4; ++m) { const unsigned row = (unsigned)(u.pm * 256 + ai * 128 + wr * 64 + m * 16 + fr); bf16_t* rp = O + ((size_t)row * (unsigned)ldc + (unsigned)(u.pn * 256 + wc * 32 + 8 * fq));
#pragma unroll
                for (int bj = 0; bj < 2; ++bj) st_bf16x8(rp + bj * 128, acc[ai][bj][m][0], acc[ai][bj][m][1]); }
    }
};
struct EpiStoreBf16S {
    static constexpr int NSTORES = 16; static constexpr bool PERM = true;
    bf16_t* O; int ldc; float scale;
    __device__ __forceinline__ void operator()(const f32x4 (&acc)[2][2][4][2], const Unit& u, int wr, int wc, int fr, int fq) const {
#pragma unroll
        for (int ai = 0; ai < 2; ++ai)
#pragma unroll
            for (int m = 0; m < 4; ++m) { const unsigned row = (unsigned)(u.pm * 256 + ai * 128 + wr * 64 + m * 16 + fr); bf16_t* rp = O + ((size_t)row * (unsigned)ldc + (unsigned)(u.pn * 256 + wc * 32 + 8 * fq));
#pragma unroll
                for (int bj = 0; bj < 2; ++bj) st_bf16x8(rp + bj * 128, acc[ai][bj][m][0] * scale, acc[ai][bj][m][1] * scale); }
    }
};
struct EpiQ {
    static constexpr int NSTORES = 32; static constexpr bool PERM = false;
    bf16_t* q; const float* rstd; const float* cs; const float* sn;
    LAS unsigned char* lds;
    static constexpr int RS_LDS = 141312;
    __device__ __forceinline__ void prefetch(const Unit& u, int lane, int wid) const {
        if (wid == 0) __builtin_amdgcn_global_load_lds((const unsigned*)(rstd + u.pm * 256 + 4 * lane), (LAS unsigned*)(lds + RS_LDS + (u.ui % 3) * 1024), 16, 0, 0);
    }
    __device__ __forceinline__ void operator()(const f32x4 (&acc)[2][2][4][2], const Unit& u, int wr, int wc, int fr, int fq) const {
        const bool rope = (u.pn == 2);
        float rsv[2][4];
#pragma unroll
        for (int ai = 0; ai < 2; ++ai)
#pragma unroll
            for (int m = 0; m < 4; ++m) rsv[ai][m] = ((const LAS float*)(lds + RS_LDS + (u.ui % 3) * 1024))[ai * 128 + wr * 64 + m * 16 + fr];
#pragma unroll
        for (int ai = 0; ai < 2; ++ai) {
            f32x4 c4m[4], s4m[4];
#pragma unroll
            for (int m = 0; m < 4; ++m) { c4m[m] = (f32x4){1.f, 1.f, 1.f, 1.f}; s4m[m] = (f32x4){0.f, 0.f, 0.f, 0.f}; }
            if (rope) {
#pragma unroll
                for (int m = 0; m < 4; ++m) { const unsigned row = (unsigned)(u.pm * 256 + ai * 128 + wr * 64 + m * 16 + fr); c4m[m] = *(const f32x4*)(cs + (row * 16u + 4u * fq)); s4m[m] = *(const f32x4*)(sn + (row * 16u + 4u * fq)); } }
#pragma unroll
            for (int m = 0; m < 4; ++m) { const unsigned row = (unsigned)(u.pm * 256 + ai * 128 + wr * 64 + m * 16 + fr); const float rs = rsv[ai][m];
                bf16_t* rp = q + (row * 768u + (unsigned)(u.pn * 256 + wc * 32 + 4 * fq));
                const f32x4 c4 = c4m[m], s4 = s4m[m];
#pragma unroll
                for (int bj = 0; bj < 2; ++bj) { const f32x4 x1 = acc[ai][bj][m][0] * rs, x2 = acc[ai][bj][m][1] * rs;
                    st_bf16x4(rp + bj * 128, x1 * c4 - x2 * s4); st_bf16x4(rp + bj * 128 + 16, x2 * c4 + x1 * s4); }
                asm volatile("" ::: "memory"); } }
    }
};
struct EpiK {
    static constexpr int NSTORES = 16; static constexpr bool PERM = true;
    bf16_t* kk; const float* rstd;
    LAS unsigned char* lds;
    static constexpr int RS_LDS = 141312;
    __device__ __forceinline__ void prefetch(const Unit& u, int lane, int wid) const {
        if (wid == 0) __builtin_amdgcn_global_load_lds((const unsigned*)(rstd + u.pm * 256 + 4 * lane), (LAS unsigned*)(lds + RS_LDS + (u.ui % 3) * 1024), 16, 0, 0);
    }
    __device__ __forceinline__ void operator()(const f32x4 (&acc)[2][2][4][2], const Unit& u, int wr, int wc, int fr, int fq) const {
        float rsv[2][4];
#pragma unroll
        for (int ai = 0; ai < 2; ++ai)
#pragma unroll
            for (int m = 0; m < 4; ++m) rsv[ai][m] = ((const LAS float*)(lds + RS_LDS + (u.ui % 3) * 1024))[ai * 128 + wr * 64 + m * 16 + fr];
#pragma unroll
        for (int ai = 0; ai < 2; ++ai)
#pragma unroll
            for (int m = 0; m < 4; ++m) { const unsigned row = (unsigned)(u.pm * 256 + ai * 128 + wr * 64 + m * 16 + fr); const float rs = rsv[ai][m];
                bf16_t* rp = kk + (row * 512u + (unsigned)(u.pn * 256 + wc * 32 + 8 * fq));
#pragma unroll
                for (int bj = 0; bj < 2; ++bj) st_bf16x8(rp + bj * 128, acc[ai][bj][m][0] * rs, acc[ai][bj][m][1] * rs);
                asm volatile("" ::: "memory"); }
    }
};
struct EpiVT {
    static constexpr int NSTORES = 32; static constexpr bool PERM = false;
    bf16_t* vt; const float* rstd;
    LAS unsigned char* lds;
    static constexpr int RS_LDS = 141312;
    __device__ __forceinline__ void prefetch(const Unit& u, int lane, int wid) const {
        if (wid == 0) __builtin_amdgcn_global_load_lds((const unsigned*)(rstd + u.pm * 256 + 4 * lane), (LAS unsigned*)(lds + RS_LDS + (u.ui % 3) * 1024), 16, 0, 0);
    }
    __device__ __forceinline__ void operator()(const f32x4 (&acc)[2][2][4][2], const Unit& u, int wr, int wc, int fr, int fq) const {
        f32x4 rsv[2][4];
#pragma unroll
        for (int ai = 0; ai < 2; ++ai)
#pragma unroll
            for (int m = 0; m < 4; ++m) rsv[ai][m] = *(const LAS f32x4*)((const LAS float*)(lds + RS_LDS + (u.ui % 3) * 1024) + ai * 128 + wr * 64 + m * 16 + 4 * fq);
#pragma unroll
        for (int ai = 0; ai < 2; ++ai) { const unsigned row0 = (unsigned)(u.pm * 256 + ai * 128 + wr * 64); const unsigned b = row0 >> 12, chunk = (row0 & 4095u) >> 6;
#pragma unroll
            for (int m = 0; m < 4; ++m) { const f32x4 rs = rsv[ai][m]; const unsigned pos = (unsigned)(32 * (m >> 1) + 8 * fq + 4 * (m & 1));
#pragma unroll
                for (int bj = 0; bj < 2; ++bj)
#pragma unroll
                    for (int n = 0; n < 2; ++n) { const unsigned c = (unsigned)(u.pn * 256 + bj * 128 + wc * 32 + n * 16 + fr), h = c >> 6, d = c & 63u;
                        st_bf16x4(vt + ((((b * 8u + h) * 64u + chunk) * 64u + d) * 64u + pos), acc[ai][bj][m][n] * rs); }
                asm volatile("" ::: "memory"); } }
    }
};
struct EpiRouter {
    static constexpr int NSTORES = 0; static constexpr bool PERM = false;
    float* logits; const float* bias;
    __device__ __forceinline__ void operator()(const f32x4 (&acc)[2][2][4][2], const Unit& u, int wr, int wc, int fr, int fq) const {
        if (wc != 0) return;
#pragma unroll
        for (int ai = 0; ai < 2; ++ai)
#pragma unroll
            for (int m = 0; m < 4; ++m) { const int row = u.pm * 256 + ai * 128 + wr * 64 + m * 16 + fr;
#pragma unroll
                for (int n = 0; n < 2; ++n) { const int c = n * 16 + 4 * fq; *(f32x4*)(logits + (size_t)row * 32 + c) = acc[ai][0][m][n] + *(const f32x4*)(bias + c); } }
    }
};
constexpr float W8_SCALE = 32.f, W8_INV = 1.f / 32.f;
struct EpiGU {
    static constexpr int NSTORES = 8; static constexpr bool PERM = true;
    unsigned char* act; const float* bias; int base; LAS unsigned char* lds;
    static constexpr int BIAS_LDS = 141312;
    __device__ __forceinline__ void prefetch(const Unit& u, int lane, int wid) const {
        if (wid != 0) return;
        const float* src = bias + (size_t)u.e * 2048 + u.pn * 128 + (lane < 32 ? 4 * lane : 1024 + 4 * (lane - 32));
        __builtin_amdgcn_global_load_lds((const unsigned*)src, (LAS unsigned*)(lds + BIAS_LDS + (u.ui & 1) * 1024), 16, 0, 0);
    }
    __device__ __forceinline__ void init_acc(f32x4 (&acc)[2][2][4][2], const Unit& u, int wc, int fq, bool from_lds) const {
        f32x4 bg[2], bl[2];
        if (from_lds) { const LAS float* bq = (const LAS float*)(lds + BIAS_LDS + (u.ui & 1) * 1024) + wc * 32 + 8 * fq;
#pragma unroll
            for (int n = 0; n < 2; ++n) { bg[n] = *(const LAS f32x4*)(bq + 4 * n); bl[n] = *(const LAS f32x4*)(bq + 128 + 4 * n); } }
        else { const float* be = bias + (size_t)u.e * 2048 + u.pn * 128 + wc * 32 + 8 * fq;
#pragma unroll
            for (int n = 0; n < 2; ++n) { bg[n] = *(const f32x4*)(be + 4 * n); bl[n] = *(const f32x4*)(be + 1024 + 4 * n); } }
#pragma unroll
        for (int n = 0; n < 2; ++n) { bg[n] = bg[n] * 32.f; bl[n] = (bl[n] + 1.f) * 32.f; }
#pragma unroll
        for (int ai = 0; ai < 2; ++ai)
#pragma unroll
            for (int m = 0; m < 4; ++m)
#pragma unroll
                for (int n = 0; n < 2; ++n) { acc[ai][0][m][n] = bg[n]; acc[ai][1][m][n] = bl[n]; }
    }
    __device__ __forceinline__ void operator()(const f32x4 (&acc)[2][2][4][2], const Unit& u, int wr, int wc, int fr, int fq) const {
        const int j = u.pn * 128 + wc * 32 + 8 * fq;
#pragma unroll
        for (int ai = 0; ai < 2; ++ai)
#pragma unroll
            for (int m = 0; m < 4; ++m) { const int arow = u.arow0 - base + ai * 128 + wr * 64 + m * 16 + fr; u32x2 w;
#pragma unroll
                for (int n = 0; n < 2; ++n) { const f32x4 g4 = acc[ai][0][m][n], l4 = acc[ai][1][m][n]; f32x2 o[2];
#pragma unroll
                    for (int h = 0; h < 2; ++h) {
                        const f32x2 g = {fminf(g4[2 * h], 7.f * 32.f), fminf(g4[2 * h + 1], 7.f * 32.f)};
                        const f32x2 l = {__builtin_amdgcn_fmed3f(l4[2 * h], -6.f * 32.f, 8.f * 32.f), __builtin_amdgcn_fmed3f(l4[2 * h + 1], -6.f * 32.f, 8.f * 32.f)};
                        const f32x2 e = g * (-1.702f * 1.4426950408889634f / 32.f);
                        f32x2 d = {__builtin_amdgcn_exp2f(e[0]), __builtin_amdgcn_exp2f(e[1])}; d = d * 1024.f + 1024.f;
                        const f32x2 r = {__builtin_amdgcn_rcpf(d[0]), __builtin_amdgcn_rcpf(d[1])};
                        o[h] = (g * r) * l; }
                    w[n] = pk4_fp8(o[0][0], o[0][1], o[1][0], o[1][1]); }
                *(u32x2*)(act + ((unsigned)arow * 1024u + (unsigned)j)) = w; }
    }
};
struct EpiDown {
    static constexpr int NSTORES = 16; static constexpr bool PERM = true;
    unsigned char* y4; const float* bias; const int* slot_y; const float* slot_g; LAS unsigned char* lds;
    static constexpr int BIAS_LDS = 141312;
    __device__ __forceinline__ void prefetch(const Unit& u, int lane, int wid) const {
        LAS unsigned char* buf = lds + BIAS_LDS + (u.ui % 3) * 3072;
        if (wid == 0) __builtin_amdgcn_global_load_lds((const unsigned*)(bias + (size_t)u.e * 1024 + u.pn * 256 + 4 * lane), (LAS unsigned*)buf, 16, 0, 0);
        else if (wid == 1) __builtin_amdgcn_global_load_lds((const unsigned*)(slot_y + u.arow0 + 4 * lane), (LAS unsigned*)(buf + 1024), 16, 0, 0);
        else if (wid == 2) __builtin_amdgcn_global_load_lds((const unsigned*)(slot_g + u.arow0 + 4 * lane), (LAS unsigned*)(buf + 2048), 16, 0, 0);
    }
    __device__ __forceinline__ void init_acc(f32x4 (&acc)[2][2][4][2], const Unit& u, int wc, int fq, bool from_lds) const {
        f32x4 bv[2][2];
        if (from_lds) {
            const unsigned ba = (unsigned)(size_t)(lds + BIAS_LDS + (u.ui % 3) * 3072) + (unsigned)(wc * 32 + 8 * fq) * 4u;
            asm volatile("ds_read_b128 %0, %4\n\tds_read_b128 %1, %4 offset:16\n\tds_read_b128 %2, %4 offset:512\n\tds_read_b128 %3, %4 offset:528\n\ts_waitcnt lgkmcnt(0)"
                         : "=&v"(bv[0][0]), "=&v"(bv[0][1]), "=&v"(bv[1][0]), "=&v"(bv[1][1]) : "v"(ba) : "memory"); }
        else { const float* be = bias + (size_t)u.e * 1024 + u.pn * 256 + wc * 32 + 8 * fq;
#pragma unroll
            for (int bj = 0; bj < 2; ++bj)
#pragma unroll
                for (int n = 0; n < 2; ++n) bv[bj][n] = *(const f32x4*)(be + bj * 128 + 4 * n); }
#pragma unroll
        for (int ai = 0; ai < 2; ++ai)
#pragma unroll
            for (int bj = 0; bj < 2; ++bj)
#pragma unroll
                for (int m = 0; m < 4; ++m)
#pragma unroll
                    for (int n = 0; n < 2; ++n) acc[ai][bj][m][n] = bv[bj][n] * 32.f;
    }
    __device__ __forceinline__ void operator()(const f32x4 (&acc)[2][2][4][2], const Unit& u, int wr, int wc, int fr, int fq) const {
        const int d0 = u.pn * 256 + wc * 32 + 8 * fq;
        int yrv[2][4]; float gv[2][4];
        { const unsigned ya = (unsigned)(size_t)(lds + BIAS_LDS + (u.ui % 3) * 3072 + 1024) + (unsigned)(wr * 64 + fr) * 4u;
#pragma unroll
            for (int ai = 0; ai < 2; ++ai)
#pragma unroll
                for (int m = 0; m < 4; ++m) asm volatile("ds_read_b32 %0, %2 offset:%3\n\tds_read_b32 %1, %2 offset:%4" : "=&v"(yrv[ai][m]), "=&v"(gv[ai][m]) : "v"(ya), "n"((ai * 128 + m * 16) * 4), "n"((ai * 128 + m * 16) * 4 + 1024) : "memory");
            asm volatile("s_waitcnt lgkmcnt(0)" ::: "memory");
#pragma unroll
            for (int ai = 0; ai < 2; ++ai)
#pragma unroll
                for (int m = 0; m < 4; ++m) asm volatile("" : "+v"(yrv[ai][m]), "+v"(gv[ai][m])); }
#pragma unroll
        for (int ai = 0; ai < 2; ++ai)
#pragma unroll
            for (int m = 0; m < 4; ++m) { const int yr = yrv[ai][m]; const float sg = gv[ai][m] * W8_INV;
                { unsigned char* rp = y4 + ((ptrdiff_t)yr * 1024 + d0);
#pragma unroll
                    for (int bj = 0; bj < 2; ++bj) { const f32x4 a = acc[ai][bj][m][0] * sg, b2 = acc[ai][bj][m][1] * sg;
                        u32x2 w; w.x = pk4_fp8(a[0], a[1], a[2], a[3]); w.y = pk4_fp8(b2[0], b2[1], b2[2], b2[3]); *(u32x2*)(rp + bj * 128) = w; } } }
    }
};

template <class T, class = void> struct epi_has_prefetch { static constexpr bool value = false; };
template <class T> struct epi_has_prefetch<T, decltype((void)&T::prefetch)> { static constexpr bool value = true; };
template <class T, class = void> struct epi_has_fold { static constexpr bool value = false; };
template <class T> struct epi_has_fold<T, decltype((void)&T::init_acc)> { static constexpr bool value = true; };
static_assert(epi_has_fold<EpiGU>::value && epi_has_fold<EpiDown>::value && !epi_has_fold<EpiStoreBf16S>::value, "fold detection");
namespace pg8 {
constexpr int BK = 64, HALF = 128, HTB = HALF * BK * 2, STAGE_BYTES = 8 * HTB;
__device__ __forceinline__ int lds_byte(int r, int c) { const int st = (r >> 4) * 2 + (c >> 5), rr = r & 15, cc = c & 31, ob = rr * 64 + cc * 2; return st * 1024 + (ob ^ (((ob >> 9) & 1) << 5)); }
__device__ __forceinline__ void stage_rc(int b, int& R, int& C) { const int st = b / 1024, sb = b % 1024, swz = sb ^ (((sb >> 9) & 1) << 5); R = (st >> 1) * 16 + swz / 64; C = (st & 1) * 32 + (swz % 64) / 2; }

typedef int i32x4 __attribute__((ext_vector_type(4)));
typedef int i32x8 __attribute__((ext_vector_type(8)));
__device__ __forceinline__ int perm32(int rho) { const int n = rho >> 4, i = rho & 15; return 8 * (i >> 2) + 4 * n + (i & 3); }
template <class Epi, class Sched, bool GATHER, bool ALIGN_EPI, bool SWAP = false, bool FP8 = false>
__device__ __forceinline__ void gemm_phase_mfma(LAS unsigned char* lds, const Gemm g, const Sched& S, const Epi& E) {
    const int tid = threadIdx.x, wid = __builtin_amdgcn_readfirstlane(tid >> 6), lane = tid & 63, wr = wid >> 2, wc = wid & 3, fr = lane & 15, fq = lane >> 4;
    constexpr int ESZ = FP8 ? 1 : 2; const int K = g.K, nt = (K * ESZ) / (BK * 2); const unsigned lda2 = (unsigned)g.lda * (unsigned)ESZ; const unsigned rowB = (unsigned)K * (unsigned)ESZ;
    int sR[2], sC[2];
    unsigned voffB[2], cvA[2][2]; int nidx[2][2];
#pragma unroll
    for (int i = 0; i < 2; ++i) { stage_rc(tid * 16 + i * 8192, sR[i], sC[i]); const int rB = Epi::PERM ? ((sR[i] & ~31) + perm32(sR[i] & 31)) : sR[i]; voffB[i] = (unsigned)rB * rowB + (unsigned)sC[i] * 2u; }
    const size_t kstep = (size_t)(BK * 2);
    const size_t hstepB = (size_t)HALF * rowB;
    const unsigned ldsw = (unsigned)wid * 1024u;
    const int aoff = lds_byte(wr * 64 + fr, fq * 8), boff = lds_byte(wc * 32 + fr, fq * 8);
    const int rmask = ((nt & (nt - 1)) == 0) ? (nt - 1) : 0; const int wrapmask = rmask ? rmask : 0x7fffffff;
#define PG8_ROT(u) (((u).pn + 2 * ((u).pm & 3)) & rmask)
#define PG8_KO(t, r) ((size_t)(((t) + (r)) & wrapmask) * kstep)
#define PG8_SA(b, h) (((b) * 2 + (h)) * HTB)
#define PG8_SB(b, h) ((4 + (b) * 2 + (h)) * HTB)
#define PG8_STAGE(bufoff, gbase, voff) do { _Pragma("unroll") for (int _i = 0; _i < 2; ++_i) \
        __builtin_amdgcn_global_load_lds((const unsigned*)((const char*)(gbase) + (voff)[_i]), (LAS unsigned*)(lds + (bufoff) + ldsw + _i * 8192), 16, 0, 0); } while (0)
#define PG8_LDA(dst, b, h) do { _Pragma("unroll") for (int m = 0; m < 4; ++m) { if constexpr (FP8) { const i32x4 lo_ = *(const LAS i32x4*)(lds + PG8_SA(b, h) + aoff + m * 2048), hi_ = *(const LAS i32x4*)(lds + PG8_SA(b, h) + aoff + m * 2048 + 1024); dst##8[m] = __builtin_shufflevector(lo_, hi_, 0, 1, 2, 3, 4, 5, 6, 7); } \
        else { _Pragma("unroll") for (int k = 0; k < 2; ++k) dst[m][k] = *(const LAS bf16x8*)(lds + PG8_SA(b, h) + aoff + m * 2048 + k * 1024); } } } while (0)
#define PG8_LDB(dst, b, h) do { _Pragma("unroll") for (int n = 0; n < 2; ++n) { if constexpr (FP8) { const i32x4 lo_ = *(const LAS i32x4*)(lds + PG8_SB(b, h) + boff + n * 2048), hi_ = *(const LAS i32x4*)(lds + PG8_SB(b, h) + boff + n * 2048 + 1024); dst##8[n] = __builtin_shufflevector(lo_, hi_, 0, 1, 2, 3, 4, 5, 6, 7); } \
        else { _Pragma("unroll") for (int k = 0; k < 2; ++k) dst[n][k] = *(const LAS bf16x8*)(lds + PG8_SB(b, h) + boff + n * 2048 + k * 1024); } } } while (0)
#define PG8_MMA(ai, bj, At, Bt) do { __builtin_amdgcn_s_setprio(1); _Pragma("unroll") for (int m = 0; m < 4; ++m) _Pragma("unroll") for (int n = 0; n < 2; ++n) { \
        if constexpr (FP8) { asm volatile("v_mfma_f32_16x16x128_f8f6f4 %0, %1, %2, %0" : "+v"(acc[ai][bj][m][n]) : "v"(Bt##8[n]), "v"(At##8[m])); } \
        else { _Pragma("unroll") for (int k = 0; k < 2; ++k) \
            acc[ai][bj][m][n] = SWAP ? __builtin_amdgcn_mfma_f32_16x16x32_bf16(At[m][k], Bt[n][k], acc[ai][bj][m][n], 0, 0, 0) : __builtin_amdgcn_mfma_f32_16x16x32_bf16(Bt[n][k], At[m][k], acc[ai][bj][m][n], 0, 0, 0); } } \
        __builtin_amdgcn_s_setprio(0); } while (0)
#define PG8_WAIT_V(n) asm volatile("s_waitcnt vmcnt(" #n ")" ::: "memory")
    constexpr int RELAX = 8 + Epi::NSTORES;
#define PG8_WAIT_V8R(relax) do { if (relax) asm volatile("s_waitcnt vmcnt(%0)" :: "n"(RELAX) : "memory"); else asm volatile("s_waitcnt vmcnt(8)" ::: "memory"); } while (0)
#define PG8_WAIT_L(n) asm volatile("s_waitcnt lgkmcnt(" #n ")" ::: "memory")
#define PG8_BAR __builtin_amdgcn_s_barrier()
#define PG8_SCHED __builtin_amdgcn_sched_barrier(0)
    Unit cur, nxt; int ui = 0;
    if (!S.next(0, cur)) return;
    f32x4 acc[2][2][4][2];
    if constexpr (epi_has_prefetch<Epi>::value) {
        E.prefetch(cur, lane, wid);
        Unit u1; if (S.next(1, u1)) E.prefetch(u1, lane, wid); }
    if constexpr (epi_has_fold<Epi>::value) E.init_acc(acc, cur, wc, fq, false);
    else {
#pragma unroll
    for (int a = 0; a < 2; ++a)
#pragma unroll
        for (int b = 0; b < 2; ++b)
#pragma unroll
            for (int m = 0; m < 4; ++m)
#pragma unroll
                for (int n = 0; n < 2; ++n) acc[a][b][m][n] = (f32x4){0.f, 0.f, 0.f, 0.f};
    }
    bf16x8 At[4][2], B0[2][2], B1[2][2]; i32x8 At8[4], B08[2], B18[2];
#pragma unroll
    for (int h = 0; h < 2; ++h)
#pragma unroll
        for (int i = 0; i < 2; ++i) { const int row = GATHER ? g.gather[cur.arow0 + h * HALF + sR[i]] : (h * HALF + sR[i]); cvA[h][i] = (unsigned)row * lda2 + (unsigned)sC[i] * 2u; nidx[h][i] = 0; }
    const char* cA = (const char*)g.A + (GATHER ? (size_t)0 : (size_t)cur.arow0 * lda2); const char* cB = (const char*)g.Bt + (size_t)cur.brow0 * rowB;
    int rc = PG8_ROT(cur), rn = rc;
    PG8_STAGE(PG8_SB(0, 0), cB + PG8_KO(0, rc), voffB); PG8_STAGE(PG8_SB(0, 1), cB + hstepB + PG8_KO(0, rc), voffB); PG8_STAGE(PG8_SA(0, 0), cA + PG8_KO(0, rc), cvA[0]); PG8_STAGE(PG8_SA(0, 1), cA + PG8_KO(0, rc), cvA[1]);
    if (wr == 1) PG8_BAR;
    PG8_WAIT_V(2); PG8_BAR;
    PG8_STAGE(PG8_SB(1, 0), cB + PG8_KO(1, rc), voffB); PG8_STAGE(PG8_SA(1, 0), cA + PG8_KO(1, rc), cvA[0]); PG8_STAGE(PG8_SB(1, 1), cB + hstepB + PG8_KO(1, rc), voffB);
    PG8_WAIT_V(6); PG8_BAR;
    const char* pre_a = cA; unsigned pre_v[2] = {0u, 0u};
    for (;;) {
        const bool has_next = S.next(ui + 1, nxt);
        const char* nA = has_next ? (const char*)g.A + (GATHER ? (size_t)0 : (size_t)nxt.arow0 * lda2) : cA; const char* nB = has_next ? (const char*)g.Bt + (size_t)nxt.brow0 * rowB : cB; rn = has_next ? PG8_ROT(nxt) : rc;
        if (GATHER && has_next) {
#pragma unroll
            for (int h = 0; h < 2; ++h)
#pragma unroll
                for (int i = 0; i < 2; ++i) { const int* ip = g.gather + nxt.arow0 + h * HALF + sR[i]; asm volatile("global_load_dword %0, %1, off" : "=v"(nidx[h][i]) : "v"(ip) : "memory"); }
        }
#pragma unroll 1
        for (int t = 0; t < nt; t += 2) {
            const bool last = (t == nt - 2);
            const char* a1 = cA + PG8_KO(t + 1, rc);
            const size_t k2 = last ? PG8_KO(0, rn) : PG8_KO(t + 2, rc), k3 = last ? PG8_KO(1, rn) : PG8_KO(t + 3, rc);
            const char* a2 = (last ? nA : cA) + k2; const char* b2 = (last ? nB : cB) + k2;
            const char* a3 = (last ? nA : cA) + k3; const char* b3 = (last ? nB : cB) + k3;
            unsigned sv0[2], sv1[2];
#pragma unroll
            for (int i = 0; i < 2; ++i) { sv0[i] = cvA[0][i]; sv1[i] = cvA[1][i]; }
            if (GATHER && last && has_next) {
#pragma unroll
                for (int i = 0; i < 2; ++i) { asm volatile("" : "+v"(nidx[0][i]), "+v"(nidx[1][i])); sv0[i] = (unsigned)nidx[0][i] * lda2 + (unsigned)sC[i] * 2u; sv1[i] = (unsigned)nidx[1][i] * lda2 + (unsigned)sC[i] * 2u; }
            }
            const bool first = (t == 0) && (ui > 0);
            const bool relax = first && (Epi::NSTORES > 0);
            if (last) { pre_a = a3; pre_v[0] = sv1[0]; pre_v[1] = sv1[1]; }
            PG8_LDB(B0, 0, 0); PG8_LDB(B1, 0, 1); PG8_SCHED; PG8_LDA(At, 0, 0); if (!first) PG8_STAGE(PG8_SA(1, 1), a1, cvA[1]);
            PG8_WAIT_V8R(relax); PG8_WAIT_L(0); PG8_BAR; PG8_MMA(0, 0, At, B0); PG8_MMA(0, 1, At, B1); PG8_BAR; PG8_SCHED;
            PG8_LDA(At, 0, 1); PG8_STAGE(PG8_SB(0, 0), b2, voffB); PG8_STAGE(PG8_SB(0, 1), b2 + hstepB, voffB); PG8_STAGE(PG8_SA(0, 0), a2, sv0);
            PG8_WAIT_V8R(relax); PG8_WAIT_L(0); PG8_BAR; PG8_MMA(1, 0, At, B0); PG8_MMA(1, 1, At, B1); PG8_BAR; PG8_SCHED;
            PG8_LDB(B0, 1, 0); PG8_LDB(B1, 1, 1); PG8_SCHED; PG8_LDA(At, 1, 0); PG8_STAGE(PG8_SA(0, 1), a2, sv1);
            PG8_WAIT_V8R(relax); PG8_WAIT_L(0); PG8_BAR; PG8_MMA(0, 0, At, B0); PG8_MMA(0, 1, At, B1); PG8_BAR; PG8_SCHED;
            PG8_LDA(At, 1, 1); PG8_STAGE(PG8_SB(1, 0), b3, voffB); PG8_STAGE(PG8_SB(1, 1), b3 + hstepB, voffB); PG8_STAGE(PG8_SA(1, 0), a3, sv0);
            PG8_WAIT_V(8); PG8_WAIT_L(0); PG8_BAR; PG8_MMA(1, 0, At, B0); PG8_MMA(1, 1, At, B1); PG8_BAR; PG8_SCHED;
        }
        if (has_next) PG8_STAGE(PG8_SA(1, 1), pre_a, pre_v);
        asm volatile("" ::: "memory");
        if constexpr (epi_has_prefetch<Epi>::value) { Unit u2; if (S.next(ui + 2, u2)) E.prefetch(u2, lane, wid); asm volatile("" ::: "memory"); }
        if constexpr (ALIGN_EPI) { if (wr == 0) PG8_BAR; }
        if constexpr (FP8) {
#define PG8_ACC8(a_, b_) "+v"(acc[a_][b_][0][0]), "+v"(acc[a_][b_][0][1]), "+v"(acc[a_][b_][1][0]), "+v"(acc[a_][b_][1][1]), "+v"(acc[a_][b_][2][0]), "+v"(acc[a_][b_][2][1]), "+v"(acc[a_][b_][3][0]), "+v"(acc[a_][b_][3][1])
            asm volatile("s_nop 15\n\ts_nop 15\n\ts_nop 15" : PG8_ACC8(0, 0) :: "memory");
            asm volatile("" : PG8_ACC8(0, 1)); asm volatile("" : PG8_ACC8(1, 0)); asm volatile("" : PG8_ACC8(1, 1));
#undef PG8_ACC8
        }
        E(acc, cur, wr, wc, fr, fq);
        if (!has_next) break;
        if constexpr (epi_has_fold<Epi>::value) E.init_acc(acc, nxt, wc, fq, true);
        else {
#pragma unroll
        for (int a = 0; a < 2; ++a)
#pragma unroll
            for (int b = 0; b < 2; ++b)
#pragma unroll
                for (int m = 0; m < 4; ++m)
#pragma unroll
                    for (int n = 0; n < 2; ++n) acc[a][b][m][n] = (f32x4){0.f, 0.f, 0.f, 0.f};
        }
        cur = nxt; cA = nA; cB = nB; rc = rn; ++ui;
        if (GATHER) {
#pragma unroll
            for (int h = 0; h < 2; ++h)
#pragma unroll
                for (int i = 0; i < 2; ++i) cvA[h][i] = (unsigned)nidx[h][i] * lda2 + (unsigned)sC[i] * 2u;
        }
        if constexpr (ALIGN_EPI) { if (wr == 1) PG8_BAR; }
    }
    PG8_WAIT_V(0);
    if constexpr (!ALIGN_EPI) { if (wr == 0) PG8_BAR; }
    PG8_BAR;
#undef PG8_SA
#undef PG8_ROT
#undef PG8_KO
#undef PG8_SB
#undef PG8_STAGE
#undef PG8_LDA
#undef PG8_LDB
#undef PG8_MMA
#undef PG8_WAIT_V
#undef PG8_WAIT_V8R
#undef PG8_WAIT_L
#undef PG8_BAR
#undef PG8_SCHED
}
}
#define GEMM_PHASE(l, g, S, E) pg8::gemm_phase_mfma<decltype(E), decltype(S), false, true>(l, g, S, E)
#define GEMM_PHASE_G(l, g, S, E) pg8::gemm_phase_mfma<decltype(E), decltype(S), true, true>(l, g, S, E)
#define GEMM_PHASE_F8(l, g, S, E) pg8::gemm_phase_mfma<decltype(E), decltype(S), false, true, false, true>(l, g, S, E)
#define GEMM_PHASE_F8G(l, g, S, E) pg8::gemm_phase_mfma<decltype(E), decltype(S), true, true, false, true>(l, g, S, E)
#define GEMM_PHASE_SWAP(l, g, S, E) pg8::gemm_phase_mfma<decltype(E), decltype(S), false, true, true>(l, g, S, E)

struct TrJob { const float* W; int ldw, K; bf16_t* WT; const float* kg0; const float* kg1; int ksplit; float scale;
               int nb; size_t wbs, wtbs; int nseg, segn, src0, srcstride, dst0, dststride; int q8; };
__device__ __forceinline__ void tr_item(const TrJob& J, int item, LAS float* scr, int lane) {
    const int kblocks = J.K / 64, nblk = (J.segn + 31) / 32;
    int r = item; const int kb = r % kblocks; r /= kblocks; const int nbk = r % nblk; r /= nblk; const int seg = r % J.nseg; const int b = r / J.nseg;
    const int k0 = kb * 64, nsrc = J.src0 + seg * J.srcstride + nbk * 32, ndst = J.dst0 + seg * J.dststride + nbk * 32, nvalid = J.segn - nbk * 32;
    const float* W = J.W + (size_t)b * J.wbs; bf16_t* WT = J.WT + (size_t)b * J.wtbs;
#pragma unroll 8
    for (int i = 0; i < 32; ++i) { const int kk = 2 * i + (lane >> 5), n = lane & 31, k = k0 + kk;
        float v = 0.f;
        if (n < nvalid) { v = W[(size_t)k * J.ldw + nsrc + n] * J.scale; if (J.kg0) v *= (k < J.ksplit) ? J.kg0[k] : J.kg1[k - J.ksplit]; }
        scr[kk * 33 + n] = v; }
    asm volatile("s_waitcnt lgkmcnt(0)" ::: "memory");
    const int c = lane & 7;
#pragma unroll
    for (int j = 0; j < 4; ++j) { const int n = (lane >> 3) + 8 * j; const LAS float* s = scr + (8 * c) * 33 + n;
        if (J.q8) { u32x2 o8; o8.x = pk4_fp8(clamp_fp8(s[0 * 33] * 32.f), clamp_fp8(s[1 * 33] * 32.f), clamp_fp8(s[2 * 33] * 32.f), clamp_fp8(s[3 * 33] * 32.f));
            o8.y = pk4_fp8(clamp_fp8(s[4 * 33] * 32.f), clamp_fp8(s[5 * 33] * 32.f), clamp_fp8(s[6 * 33] * 32.f), clamp_fp8(s[7 * 33] * 32.f));
            if (n < nvalid) *(u32x2*)((unsigned char*)WT + (size_t)(ndst + n) * J.K + k0 + 8 * c) = o8; }
        else { u32x4 o; o.x = pk2(s[0 * 33], s[1 * 33]); o.y = pk2(s[2 * 33], s[3 * 33]); o.z = pk2(s[4 * 33], s[5 * 33]); o.w = pk2(s[6 * 33], s[7 * 33]);
            if (n < nvalid) *(u32x4*)(WT + (size_t)(ndst + n) * J.K + k0 + 8 * c) = o; } }
    asm volatile("s_waitcnt lgkmcnt(0)" ::: "memory");
}
__device__ __forceinline__ void tr_job(const Frame& F, const TrJob& J, int& off) {
    LAS float* scr = (LAS float*)(F.lds + F.wave * 16384);
    const int nitems = J.nb * J.nseg * ((J.segn + 31) / 32) * (J.K / 64), ngw = F.G * NWAVES;
    int it = (F.bid * NWAVES + F.wave - off % ngw); if (it < 0) it += ngw;
    for (; it < nitems; it += ngw) tr_item(J, it, scr, F.lane);
    off += nitems;
}

__device__ __forceinline__ void ph0_prep(const Frame& F, const Args& args) {
    unsigned char* ws = args.ws;
    const bool split = F.G >= 192; const bool do_mod = !split || F.bid < 96, do_aux = !split || F.bid >= 96;
    Frame FA = F; if (split) { FA.bid = F.bid - 96; FA.G = F.G - 96; }
    if (do_mod) {
        LAS float* cact = (LAS float*)F.lds;
        LAS float* red = cact + 16 * 1024;
        const float* c = IN_F(1); const float* w_ada = IN_F(3); const float* b_ada = IN_F(4); float* mod = (float*)(ws + WS_MOD);
        for (int i = F.tid; i < 16 * 1024; i += NTHR) { const float v = c[i]; cact[i] = v / (1.f + expf(-v)); }
        __syncthreads();
        for (int u = F.bid; u < 96; u += F.G) {
            const int j = u * 64 + F.lane; float acc[16];
#pragma unroll
            for (int b = 0; b < 16; ++b) acc[b] = 0.f;
            for (int k0 = F.wave * 128; k0 < F.wave * 128 + 128; k0 += 32) { float w[32];
#pragma unroll
                for (int kk = 0; kk < 32; ++kk) w[kk] = w_ada[(size_t)(k0 + kk) * 6144 + j];
#pragma unroll
                for (int kk = 0; kk < 32; ++kk)
#pragma unroll
                    for (int b = 0; b < 16; ++b) acc[b] += cact[b * 1024 + k0 + kk] * w[kk]; }
#pragma unroll
            for (int b = 0; b < 16; ++b) red[(F.wave * 16 + b) * 64 + F.lane] = acc[b];
            __syncthreads();
            for (int o = F.tid; o < 1024; o += NTHR) { const int b = o >> 6, l = o & 63; float s = 0.f;
#pragma unroll
                for (int w = 0; w < 8; ++w) s += red[(w * 16 + b) * 64 + l];
                mod[b * 6144 + u * 64 + l] = s + b_ada[u * 64 + l]; }
            __syncthreads();
        }
        __syncthreads();
    }
    if (!do_aux) return;
    {
        const int* pos = IN_I(2); float* cs = (float*)(ws + WS_COS); float* sn = (float*)(ws + WS_SIN);
        const double invrev = pow(10000.0, -(double)(2 * (F.tid & 15)) / 32.0) * 0.15915494309189535;
        for (int idx = FA.bid * NTHR + F.tid; idx < NTOK * 16; idx += FA.G * NTHR) { const int tok = idx >> 4;
            const double rev = (double)pos[tok] * invrev; const float frac = (float)(rev - __builtin_rint(rev));
            cs[idx] = __builtin_amdgcn_cosf(frac); sn[idx] = __builtin_amdgcn_sinf(frac); }
    }
    const float qscale = 0.10206207261596575f * 1.4426950408889634f;
    TrJob J; int off = 0;
    J = TrJob{IN_F(6), IN_COLS, 1024, (bf16_t*)(ws + WS_WIN_T), nullptr, nullptr, 1024, 1.f, 1, 0, 0, 1, 1536, 0, 0, 0, 0, 1}; tr_job(FA, J, off);
    J = TrJob{IN_F(6), IN_COLS, 1024, (bf16_t*)(ws + WS_WIN_T), nullptr, nullptr, 1024, 1.f, 1, 0, 0, 1, 8, 1536, 0, PC_DT, 0, 1}; tr_job(FA, J, off);
    J = TrJob{IN_F(6), IN_COLS, 1024, (bf16_t*)(ws + WS_WIN_T), nullptr, nullptr, 1024, 1.f, 1, 0, 0, 1, 384, 1544, 0, PC_QA, 0, 1}; tr_job(FA, J, off);
    J = TrJob{IN_F(6), IN_COLS, 1024, (bf16_t*)(ws + WS_WIN_T), nullptr, nullptr, 1024, 1.f, 1, 0, 0, 1, 256, 1928, 0, PC_KVA, 0, 1}; tr_job(FA, J, off);
    J = TrJob{IN_F(6), IN_COLS, 1024, (bf16_t*)(ws + WS_WIN_T), nullptr, nullptr, 1024, 1.f, 1, 0, 0, 1, 32, 2184, 0, PC_KR, 0, 1}; tr_job(FA, J, off);
    J = TrJob{IN_F(14), 768, 384, (bf16_t*)(ws + WS_WQ_T), IN_F(13), IN_F(13), 384, qscale, 1, 0, 0, 8, 64, 0, 96, 0, 64}; tr_job(FA, J, off);
    J = TrJob{IN_F(14), 768, 384, (bf16_t*)(ws + WS_WQ_T), IN_F(13), IN_F(13), 384, qscale, 1, 0, 0, 8, 32, 64, 96, 512, 32}; tr_job(FA, J, off);
    J = TrJob{IN_F(16), 1024, 256, (bf16_t*)(ws + WS_WKV_T), IN_F(15), IN_F(15), 256, 1.f, 1, 0, 0, 8, 64, 0, 128, 0, 64}; tr_job(FA, J, off);
    J = TrJob{IN_F(16), 1024, 256, (bf16_t*)(ws + WS_WKV_T), IN_F(15), IN_F(15), 256, 1.f, 1, 0, 0, 8, 64, 64, 128, 512, 64}; tr_job(FA, J, off);
    J = TrJob{IN_F(18), 1024, 1024, (bf16_t*)(ws + WS_WOUT_T), IN_F(12), IN_F(17), 512, 1.f, 1, 0, 0, 1, 1024, 0, 0, 0, 0, 1}; tr_job(FA, J, off);
    J = TrJob{IN_F(21), 32, 1024, (bf16_t*)(ws + WS_WR_T), nullptr, nullptr, 1024, 1.f, 1, 0, 0, 1, 32, 0, 0, 0, 0}; tr_job(FA, J, off);
}
__device__ __forceinline__ void tr8_item(const float* W, int ldw, int K, unsigned char* WT, int nsrc, int ndst, int k0, LAS unsigned* scr, int lane) {
    const int kq = lane >> 4, n4 = lane & 15;
    f32x4 v[4][4];
#pragma unroll
    for (int i = 0; i < 4; ++i)
#pragma unroll
        for (int r = 0; r < 4; ++r) v[i][r] = __builtin_nontemporal_load((const f32x4*)(W + (size_t)(k0 + 16 * i + 4 * kq + r) * ldw + nsrc + 4 * n4));
#pragma unroll
    for (int i = 0; i < 4; ++i)
#pragma unroll
        for (int e = 0; e < 4; ++e) scr[(4 * i + kq) * 65 + 4 * n4 + e] = pk4_fp8(clamp_fp8(v[i][0][e] * W8_SCALE), clamp_fp8(v[i][1][e] * W8_SCALE), clamp_fp8(v[i][2][e] * W8_SCALE), clamp_fp8(v[i][3][e] * W8_SCALE));
    asm volatile("s_waitcnt lgkmcnt(0)" ::: "memory");
    const int c = lane & 3;
#pragma unroll
    for (int j = 0; j < 4; ++j) { const int n = (lane >> 2) + 16 * j; u32x4 o;
        o.x = scr[(4 * c + 0) * 65 + n]; o.y = scr[(4 * c + 1) * 65 + n]; o.z = scr[(4 * c + 2) * 65 + n]; o.w = scr[(4 * c + 3) * 65 + n];
        *(u32x4*)(WT + (size_t)(ndst + n) * K + k0 + 16 * c) = o; }
    asm volatile("s_waitcnt lgkmcnt(0)" ::: "memory");
}
__device__ __forceinline__ void ph_moe_weights(const Frame& F, const Args& args) {
    unsigned char* ws = args.ws; LAS unsigned* scr = (LAS unsigned*)(F.lds + F.wave * 8192);
    const int gw = F.bid * NWAVES + F.wave, NGW = F.G * NWAVES;
    for (int it = gw; it < 32 * 16 * 16; it += NGW) { const int kb = it & 15, nb = (it >> 4) & 15, e = it >> 8;
        tr8_item(IN_F(25) + (size_t)e * 1024 * 1024, 1024, 1024, ws + WS_WDN_T + (size_t)e * 1024 * 1024, nb * 64, nb * 64, kb * 64, scr, F.lane); }
}

__device__ __forceinline__ void ph1_h1(const Frame& F, const Args& args) {
    const float* x = IN_F(0); const float* gain = IN_F(5); const float* mod = (const float*)(args.ws + WS_MOD); bf16_t* h1 = (bf16_t*)(args.ws + WS_H1);
    for (int m0 = (F.bid * NWAVES + F.wave) * 4; m0 < NTOK; m0 += F.G * NWAVES * 4) {
        const int b = m0 >> 12; f32x4 v[4][4]; float ss[4];
#pragma unroll
        for (int r = 0; r < 4; ++r)
#pragma unroll
            for (int j = 0; j < 4; ++j) v[r][j] = __builtin_nontemporal_load((const f32x4*)(x + (size_t)(m0 + r) * DM + 4 * F.lane + 256 * j));
#pragma unroll
        for (int r = 0; r < 4; ++r) { float t = 0.f;
#pragma unroll
            for (int j = 0; j < 4; ++j) t += v[r][j][0] * v[r][j][0] + v[r][j][1] * v[r][j][1] + v[r][j][2] * v[r][j][2] + v[r][j][3] * v[r][j][3];
            ss[r] = t; }
#pragma unroll
        for (int o = 1; o < 64; o <<= 1) {
#pragma unroll
            for (int r = 0; r < 4; ++r) ss[r] += __shfl_xor(ss[r], o); }
#pragma unroll
        for (int j = 0; j < 4; ++j) { const int col = 4 * F.lane + 256 * j; const f32x4 g = *(const f32x4*)(gain + col), sh = *(const f32x4*)(mod + b * 6144 + col), sc = *(const f32x4*)(mod + b * 6144 + 1024 + col) + 1.f;
#pragma unroll
            for (int r = 0; r < 4; ++r) { const float rstd = 1.f / sqrtf(ss[r] * (1.f / DM) + NORM_EPS); { const f32x4 hv = v[r][j] * rstd * g * sc + sh; *(unsigned*)((unsigned char*)h1 + (size_t)(m0 + r) * DM + col) = pk4_fp8(clamp_fp8(hv[0]), clamp_fp8(hv[1]), clamp_fp8(hv[2]), clamp_fp8(hv[3])); } } }
    }
}

__device__ __forceinline__ f32x4 bf_lo4(u32x4 v) { return (f32x4){__uint_as_float(v[0] << 16), __uint_as_float(v[0] & 0xffff0000u), __uint_as_float(v[1] << 16), __uint_as_float(v[1] & 0xffff0000u)}; }
__device__ __forceinline__ f32x4 bf_hi4(u32x4 v) { return (f32x4){__uint_as_float(v[2] << 16), __uint_as_float(v[2] & 0xffff0000u), __uint_as_float(v[3] << 16), __uint_as_float(v[3] & 0xffff0000u)}; }
__device__ __forceinline__ void ph3_tokprep(const Frame& F, const Args& args) {
    unsigned char* ws = args.ws; const bf16_t* proj = (const bf16_t*)(ws + WS_PROJ); bf16_t* xbc = (bf16_t*)(ws + WS_XBC);
    const float* conv_w = IN_F(7); const float* conv_b = IN_F(8); const float* dt_bias = IN_F(9);
    float* dtb = (float*)(ws + WS_DT); float* rq = (float*)(ws + WS_RSTDQ); float* rkv = (float*)(ws + WS_RSTDKV);
    const float* cs = (const float*)(ws + WS_COS); const float* sn = (const float*)(ws + WS_SIN); bf16_t* kr = (bf16_t*)(ws + WS_KR);
    const int lane = F.lane;
    for (int m0 = (F.bid * NWAVES + F.wave) * 8; m0 < NTOK; m0 += F.G * NWAVES * 8) {
        const int s0 = m0 & (SEQ - 1);
        {   const int t = lane >> 3, part = lane & 7; const bf16_t* pr = proj + (size_t)(m0 + t) * PROJ_LD;
            { const float xv = bf2f(pr[PC_DT + part]) + dt_bias[part]; dtb[(size_t)(m0 + t) * 8 + part] = xv > 20.f ? xv : log1pf(expf(xv)); }
            float sq = 0.f, skv = 0.f;
#pragma unroll
            for (int i = 0; i < 6; ++i) { const u32x4 v = *(const u32x4*)(pr + PC_QA + part * 48 + 8 * i); const f32x4 a = bf_lo4(v), b2 = bf_hi4(v); sq += a[0] * a[0] + a[1] * a[1] + a[2] * a[2] + a[3] * a[3] + b2[0] * b2[0] + b2[1] * b2[1] + b2[2] * b2[2] + b2[3] * b2[3]; }
#pragma unroll
            for (int i = 0; i < 4; ++i) { const u32x4 v = *(const u32x4*)(pr + PC_KVA + part * 32 + 8 * i); const f32x4 a = bf_lo4(v), b2 = bf_hi4(v); skv += a[0] * a[0] + a[1] * a[1] + a[2] * a[2] + a[3] * a[3] + b2[0] * b2[0] + b2[1] * b2[1] + b2[2] * b2[2] + b2[3] * b2[3]; }
#pragma unroll
            for (int o = 1; o < 8; o <<= 1) { sq += __shfl_xor(sq, o); skv += __shfl_xor(skv, o); }
            if (part == 0) { rq[m0 + t] = 1.f / sqrtf(sq * (1.f / Q_LORA) + NORM_EPS); rkv[m0 + t] = 1.f / sqrtf(skv * (1.f / KV_LORA) + NORM_EPS); }
            const unsigned x1p = *(const unsigned*)(pr + PC_KR + 2 * part), x2p = *(const unsigned*)(pr + PC_KR + 16 + 2 * part);
            const f32x2 c2 = *(const f32x2*)(cs + (size_t)(m0 + t) * 16 + 2 * part), s2 = *(const f32x2*)(sn + (size_t)(m0 + t) * 16 + 2 * part);
            const float x1a = __uint_as_float(x1p << 16), x1b = __uint_as_float(x1p & 0xffff0000u), x2a = __uint_as_float(x2p << 16), x2b = __uint_as_float(x2p & 0xffff0000u);
            *(unsigned*)(kr + (size_t)(m0 + t) * 32 + 2 * part) = pk2(x1a * c2[0] - x2a * s2[0], x1b * c2[1] - x2b * s2[1]);
            *(unsigned*)(kr + (size_t)(m0 + t) * 32 + 16 + 2 * part) = pk2(x2a * c2[0] + x1a * s2[0], x2b * c2[1] + x1b * s2[1]);
        }
#pragma unroll
        for (int j = 0; j < 2; ++j) { const int ch = 8 * lane + 512 * j;
            u32x4 v[11];
#pragma unroll
            for (int r = 0; r < 11; ++r) { if (r >= 3 || s0 > 0) v[r] = *(const u32x4*)(proj + (size_t)(m0 + r - 3) * PROJ_LD + PC_XBC + ch); else v[r] = (u32x4){0u, 0u, 0u, 0u}; }
            f32x4 wl[4], wh[4];
#pragma unroll
            for (int jj = 0; jj < 4; ++jj) { wl[jj] = *(const f32x4*)(conv_w + jj * XBC_DIM + ch); wh[jj] = *(const f32x4*)(conv_w + jj * XBC_DIM + ch + 4); }
            const f32x4 bl = *(const f32x4*)(conv_b + ch), bh = *(const f32x4*)(conv_b + ch + 4);
#pragma unroll
            for (int t = 0; t < 8; ++t) { f32x4 al = bl, ah = bh;
#pragma unroll
                for (int jj = 0; jj < 4; ++jj) { al += bf_lo4(v[t + jj]) * wl[jj]; ah += bf_hi4(v[t + jj]) * wh[jj]; }
#pragma unroll
                for (int i = 0; i < 4; ++i) { al[i] = al[i] * __builtin_amdgcn_rcpf(1.f + __expf(-al[i])); ah[i] = ah[i] * __builtin_amdgcn_rcpf(1.f + __expf(-ah[i])); }
                u32x4 o; o.x = pk2(al[0], al[1]); o.y = pk2(al[2], al[3]); o.z = pk2(ah[0], ah[1]); o.w = pk2(ah[2], ah[3]);
                *(u32x4*)(xbc + (size_t)(m0 + t) * XBC_DIM + ch) = o; } }
    }
}

constexpr size_t WS_YMIX8 = WS_Q;
constexpr size_t WS_STATES = WS_H1;
constexpr size_t WS_CDEC = 12 * MiB + 768 * 1024;
__device__ __forceinline__ int ssd_pos(int l) { return (l & 32) | (((l >> 2) & 3) << 3) | (((l >> 4) & 1) << 2) | (l & 3); }
__device__ __forceinline__ int img_off(int r, int c, int nst) { const int ob = (r & 15) * 64 + (c & 31) * 2; return ((r >> 4) * nst + (c >> 5)) * 1024 + (ob ^ (((ob >> 9) & 1) << 5)); }
__device__ __forceinline__ float wave_incl_scan(float v, int lane) {
#pragma unroll
    for (int off = 1; off < 64; off <<= 1) { const float t = __shfl_up(v, off); if (lane >= off) v += t; }
    return v;
}
template <class WF>
__device__ __forceinline__ void ssd_build_xsT(LAS unsigned char* img, const bf16_t* xbc, int m0, int h, int lane, const WF& wl) {
    const int rp = lane >> 3, cg = lane & 7;
    u32x4 v0[4], v1[4];
#pragma unroll
    for (int i = 0; i < 4; ++i) { const bf16_t* r0 = xbc + (size_t)(m0 + 2 * (8 * i + rp)) * XBC_DIM + h * 64 + 8 * cg; v0[i] = *(const u32x4*)r0; v1[i] = *(const u32x4*)(r0 + XBC_DIM); }
#pragma unroll
    for (int i = 0; i < 4; ++i) { const int l0 = 2 * (8 * i + rp), pos0 = ssd_pos(l0); const float w0 = wl(l0), w1 = wl(l0 + 1);
#pragma unroll
        for (int e = 0; e < 4; ++e) { const int p = 8 * cg + 2 * e;
            const float a0 = __uint_as_float(v0[i][e] << 16) * w0, a1 = __uint_as_float(v0[i][e] & 0xffff0000u) * w0, b0 = __uint_as_float(v1[i][e] << 16) * w1, b1 = __uint_as_float(v1[i][e] & 0xffff0000u) * w1;
            *(LAS unsigned*)(img + img_off(p, pos0, 2)) = pk2(a0, b0); *(LAS unsigned*)(img + img_off(p + 1, pos0, 2)) = pk2(a1, b1); } }
}
__device__ __forceinline__ int inv_perm32(int n) { return 16 * ((n >> 2) & 1) + 4 * (n >> 3) + (n & 3); }
__device__ __forceinline__ void ssd_phase_a(const Frame& F, const Args& args) {
    unsigned char* ws = args.ws; const bf16_t* xbc = (const bf16_t*)(ws + WS_XBC); const float* dtb = (const float*)(ws + WS_DT); bf16_t* states = (bf16_t*)(ws + WS_STATES); float* cdec = (float*)(ws + WS_CDEC);
    const int h = F.wave, gg = h >> 2, wq = h & 3, lane = F.lane, fr = lane & 15, fq = lane >> 4;
    const float a = -expf(IN_F(10)[h]);
    LAS unsigned char* xsT = F.lds + h * 8192; LAS unsigned char* BT = F.lds + 65536 + gg * 16384;
    const int foff = (fr * 64 + fq * 16) ^ ((((fr * 64 + fq * 16) >> 9) & 1) << 5);
    for (int u = F.bid; u < BATCH * NCHUNK; u += F.G) {
        const int b = u >> 6, c = u & 63, m0 = b * SEQ + c * 64;
        u32x4 bv0[2], bv1[2];
#pragma unroll
        for (int i = 0; i < 2; ++i) { const bf16_t* r0 = xbc + (size_t)(m0 + 2 * (16 * i + (lane >> 2))) * XBC_DIM + 512 + gg * 128 + 32 * wq + 8 * (lane & 3); bv0[i] = *(const u32x4*)r0; bv1[i] = *(const u32x4*)(r0 + XBC_DIM); }
        const float dtv = dtb[(size_t)(m0 + lane) * 8 + h]; const float cs = wave_incl_scan(dtv * a, lane); const float cs_end = __shfl(cs, 63);
        const float wst = dtv * __expf(cs_end - cs);
        if (lane == 0) cdec[u * 8 + h] = __expf(cs_end);
        ssd_build_xsT(xsT, xbc, m0, h, lane, [&](int l) { return __shfl(wst, l); });
#pragma unroll
        for (int i = 0; i < 2; ++i) { const int l0 = 2 * (16 * i + (lane >> 2)), pos0 = ssd_pos(l0), n0 = 32 * wq + 8 * (lane & 3);
#pragma unroll
            for (int e = 0; e < 4; ++e) { const int n = n0 + 2 * e, r0 = (n & ~31) + inv_perm32(n & 31), r1 = ((n + 1) & ~31) + inv_perm32((n + 1) & 31);
                *(LAS unsigned*)(BT + img_off(r0, pos0, 2)) = (bv0[i][e] & 0xffffu) | (bv1[i][e] << 16); *(LAS unsigned*)(BT + img_off(r1, pos0, 2)) = (bv0[i][e] >> 16) | (bv1[i][e] & 0xffff0000u); } }
        __syncthreads();
        f32x4 acc[8][4];
#pragma unroll
        for (int nb = 0; nb < 8; ++nb)
#pragma unroll
            for (int pb = 0; pb < 4; ++pb) acc[nb][pb] = (f32x4){0.f, 0.f, 0.f, 0.f};
#pragma unroll
        for (int s2 = 0; s2 < 2; ++s2) { bf16x8 xf[4];
#pragma unroll
            for (int pb = 0; pb < 4; ++pb) xf[pb] = *(const LAS bf16x8*)(xsT + (pb * 2 + s2) * 1024 + foff);
#pragma unroll
            for (int nb = 0; nb < 8; ++nb) { const bf16x8 af = *(const LAS bf16x8*)(BT + (nb * 2 + s2) * 1024 + foff);
#pragma unroll
                for (int pb = 0; pb < 4; ++pb) acc[nb][pb] = __builtin_amdgcn_mfma_f32_16x16x32_bf16(af, xf[pb], acc[nb][pb], 0, 0, 0); } }
        bf16_t* sp = states + ((size_t)u * 8 + h) * 8192;
#pragma unroll
        for (int pb = 0; pb < 4; ++pb)
#pragma unroll
            for (int k2 = 0; k2 < 4; ++k2) st_bf16x8(sp + (16 * pb + fr) * 128 + 32 * k2 + 8 * fq, acc[2 * k2][pb], acc[2 * k2 + 1][pb]);
        __syncthreads();
    }
}
__device__ __forceinline__ void ssd_phase_b(const Frame& F, const Args& args) {
    unsigned char* ws = args.ws; bf16_t* states = (bf16_t*)(ws + WS_STATES); const float* cdec = (const float*)(ws + WS_CDEC);
    for (int gid = gtid(F); gid < BATCH * 8 * 64 * 16; gid += F.G * NTHR) {
        const int n8 = gid & 15, p = (gid >> 4) & 63, h = (gid >> 10) & 7, b = gid >> 13;
        bf16_t* ptr = states + ((size_t)(b * 64) * 8 + h) * 8192 + p * 128 + n8 * 8;
        float run[8];
#pragma unroll
        for (int i = 0; i < 8; ++i) run[i] = 0.f;
        for (int c0 = 0; c0 < NCHUNK; c0 += 8) { u32x4 v[8]; float dec[8];
#pragma unroll
            for (int j = 0; j < 8; ++j) { v[j] = *(const u32x4*)(ptr + (size_t)(c0 + j) * 65536); dec[j] = cdec[(b * 64 + c0 + j) * 8 + h]; }
#pragma unroll
            for (int j = 0; j < 8; ++j) { u32x4 o; o.x = pk2(run[0], run[1]); o.y = pk2(run[2], run[3]); o.z = pk2(run[4], run[5]); o.w = pk2(run[6], run[7]);
                *(u32x4*)(ptr + (size_t)(c0 + j) * 65536) = o;
#pragma unroll
                for (int i = 0; i < 4; ++i) { run[2 * i] = run[2 * i] * dec[j] + __uint_as_float(v[j][i] << 16); run[2 * i + 1] = run[2 * i + 1] * dec[j] + __uint_as_float(v[j][i] & 0xffff0000u); } } }
    }
}
constexpr int SSDC_C = 65536, SSDC_B = 98304, SSDC_CS = 131072, SSDC_DT = 133120, SSDC_SSQ = 137216;
__device__ __forceinline__ void ssd_phase_c(const Frame& F, const Args& args) {
    unsigned char* ws = args.ws; const bf16_t* xbc = (const bf16_t*)(ws + WS_XBC); const bf16_t* proj = (const bf16_t*)(ws + WS_PROJ); const float* dtb = (const float*)(ws + WS_DT);
    const bf16_t* states = (const bf16_t*)(ws + WS_STATES); bf16_t* ymix = (bf16_t*)(ws + WS_YMIX); unsigned char* ymix8 = ws + WS_YMIX8;
    const int h = F.wave, gg = h >> 2, lane = F.lane, fr = lane & 15, fq = lane >> 4;
    const float a = -expf(IN_F(10)[h]), dsk = IN_F(11)[h];
    LAS unsigned char* xsT = F.lds + h * 8192; LAS float* csT = (LAS float*)(F.lds + SSDC_CS) + h * 64; LAS float* dtT = (LAS float*)(F.lds + SSDC_DT) + h * 64; LAS float* ssqT = (LAS float*)(F.lds + SSDC_SSQ);
    const LAS unsigned char* Cimg = F.lds + SSDC_C + gg * 16384; const LAS unsigned char* Bimg = F.lds + SSDC_B + gg * 16384;
    const int foff = (fr * 64 + fq * 16) ^ ((((fr * 64 + fq * 16) >> 9) & 1) << 5);
    const int sb_ = lane * 16, swz_ = sb_ ^ (((sb_ >> 9) & 1) << 5), rr = swz_ >> 6, cc = (swz_ & 63) >> 1;
    for (int q = 0; ; ++q) { const int pm_ = F.vcu + (q >> 2) * F.G; if (pm_ >= NTOK / 256) break; const int u = 4 * pm_ + (q & 3);
        const int b = u >> 6, c = u & 63, m0 = b * SEQ + c * 64;
#pragma unroll
        for (int k = 0; k < 8; ++k) { const int j = 8 * h + k; const int mat = j >> 5, g2 = (j >> 4) & 1, lb = (j >> 2) & 3, ns = j & 3;
            __builtin_amdgcn_global_load_lds((const unsigned*)(xbc + (size_t)(m0 + 16 * lb + rr) * XBC_DIM + (mat ? 512 : 768) + g2 * 128 + 32 * ns + cc), (LAS unsigned*)(F.lds + (mat ? SSDC_B : SSDC_C) + g2 * 16384 + (lb * 4 + ns) * 1024), 16, 0, 0); }
        const bf16_t* prev = states + ((size_t)u * 8 + h) * 8192;
        bf16x8 pfr[4][4];
#pragma unroll
        for (int pb = 0; pb < 4; ++pb)
#pragma unroll
            for (int ns = 0; ns < 4; ++ns) pfr[pb][ns] = *(const bf16x8*)(prev + (16 * pb + fr) * 128 + 32 * ns + 8 * fq);
        const float dtv = dtb[(size_t)(m0 + lane) * 8 + h]; const float cs = wave_incl_scan(dtv * a, lane);
        csT[lane] = cs; dtT[lane] = dtv;
        ssd_build_xsT(xsT, xbc, m0, h, lane, [](int) { return 1.f; });
        asm volatile("s_waitcnt vmcnt(0)" ::: "memory");
        __syncthreads();
        u32x2 yk[4][4];
#pragma unroll
        for (int lb = 0; lb < 4; ++lb) {
            const int l = 16 * lb + fr; const bf16_t* xrow = xbc + (size_t)(m0 + l) * XBC_DIM;
            u32x2 xs_r[4], z_r[4];
#pragma unroll
            for (int pb = 0; pb < 4; ++pb) { xs_r[pb] = *(const u32x2*)(xrow + h * 64 + 16 * pb + 4 * fq); z_r[pb] = *(const u32x2*)(proj + (size_t)(m0 + l) * PROJ_LD + PC_Z + h * 64 + 16 * pb + 4 * fq); }
            bf16x8 Cf[4];
#pragma unroll
            for (int ns = 0; ns < 4; ++ns) Cf[ns] = *(const LAS bf16x8*)(Cimg + (lb * 4 + ns) * 1024 + foff);
            f32x4 acc2[4];
#pragma unroll
            for (int pb = 0; pb < 4; ++pb) acc2[pb] = (f32x4){0.f, 0.f, 0.f, 0.f};
#pragma unroll
            for (int ns = 0; ns < 4; ++ns)
#pragma unroll
                for (int pb = 0; pb < 4; ++pb) acc2[pb] = __builtin_amdgcn_mfma_f32_16x16x32_bf16(pfr[pb][ns], Cf[ns], acc2[pb], 0, 0, 0);
            const float csl = csT[l]; const float ecl = __expf(csl);
            f32x4 M[4];
#pragma unroll
            for (int sb = 0; sb < 4; ++sb) M[sb] = (f32x4){0.f, 0.f, 0.f, 0.f};
#pragma unroll
            for (int ns = 0; ns < 4; ++ns)
#pragma unroll
                for (int sb = 0; sb < 4; ++sb) { if (sb <= lb) { const bf16x8 af = *(const LAS bf16x8*)(Bimg + (sb * 4 + ns) * 1024 + foff); M[sb] = __builtin_amdgcn_mfma_f32_16x16x32_bf16(af, Cf[ns], M[sb], 0, 0, 0); } }
#pragma unroll
            for (int sb = 0; sb < 4; ++sb) { if (sb <= lb) {
                    const f32x4 cs4 = *(const LAS f32x4*)(csT + 16 * sb + 4 * fq), dt4 = *(const LAS f32x4*)(dtT + 16 * sb + 4 * fq);
#pragma unroll
                    for (int i = 0; i < 4; ++i) { const int sidx = 16 * sb + 4 * fq + i; M[sb][i] = (sidx <= l) ? M[sb][i] * __expf(csl - cs4[i]) * dt4[i] : 0.f; } } }
            bf16x8 pf[2];
#pragma unroll
            for (int ks = 0; ks < 2; ++ks) { u32x4 w; w.x = pk2(M[2 * ks][0], M[2 * ks][1]); w.y = pk2(M[2 * ks][2], M[2 * ks][3]); w.z = pk2(M[2 * ks + 1][0], M[2 * ks + 1][1]); w.w = pk2(M[2 * ks + 1][2], M[2 * ks + 1][3]); pf[ks] = __builtin_bit_cast(bf16x8, w); }
            float sq = 0.f;
#pragma unroll
            for (int pb = 0; pb < 4; ++pb) { f32x4 yd = (f32x4){0.f, 0.f, 0.f, 0.f};
#pragma unroll
                for (int ks = 0; ks < 2; ++ks) { if (2 * ks <= lb) { const bf16x8 af = *(const LAS bf16x8*)(xsT + (pb * 2 + ks) * 1024 + foff); yd = __builtin_amdgcn_mfma_f32_16x16x32_bf16(af, pf[ks], yd, 0, 0, 0); } }
                const f32x4 xs4 = (f32x4){__uint_as_float(xs_r[pb].x << 16), __uint_as_float(xs_r[pb].x & 0xffff0000u), __uint_as_float(xs_r[pb].y << 16), __uint_as_float(xs_r[pb].y & 0xffff0000u)};
                const f32x4 z4 = (f32x4){__uint_as_float(z_r[pb].x << 16), __uint_as_float(z_r[pb].x & 0xffff0000u), __uint_as_float(z_r[pb].y << 16), __uint_as_float(z_r[pb].y & 0xffff0000u)};
                f32x4 yy = yd + acc2[pb] * ecl + xs4 * dsk;
#pragma unroll
                for (int i = 0; i < 4; ++i) { yy[i] *= z4[i] * __builtin_amdgcn_rcpf(1.f + __expf(-z4[i])); sq += yy[i] * yy[i]; }
                yk[lb][pb].x = pk2(yy[0], yy[1]); yk[lb][pb].y = pk2(yy[2], yy[3]); }
            sq += __shfl_xor(sq, 16); sq += __shfl_xor(sq, 32);
            if (fq == 0) ssqT[h * 64 + l] = sq;
        }
        __syncthreads();
#pragma unroll
        for (int lb = 0; lb < 4; ++lb) { const int l = 16 * lb + fr; const float tot = ssqT[(gg * 4 + 0) * 64 + l] + ssqT[(gg * 4 + 1) * 64 + l] + ssqT[(gg * 4 + 2) * 64 + l] + ssqT[(gg * 4 + 3) * 64 + l];
            const float rstd = 1.f / sqrtf(tot * (1.f / 256.f) + NORM_EPS);
#pragma unroll
            for (int pb = 0; pb < 4; ++pb) { const f32x4 t4 = (f32x4){__uint_as_float(yk[lb][pb].x << 16), __uint_as_float(yk[lb][pb].x & 0xffff0000u), __uint_as_float(yk[lb][pb].y << 16), __uint_as_float(yk[lb][pb].y & 0xffff0000u)} * rstd; *(unsigned*)(ymix8 + (size_t)(m0 + l) * 1024 + h * 64 + 4 * fq + 16 * pb) = pk4_fp8(clamp_fp8(t4[0]), clamp_fp8(t4[1]), clamp_fp8(t4[2]), clamp_fp8(t4[3])); } }
        __syncthreads();
    }
}

constexpr int ATT_KB = 12288, ATT_VB = 8192, ATT_NB = 4, ATT_V0 = ATT_NB * ATT_KB;
constexpr float ATT_THR = 8.f;
constexpr int ATT_NQ = 4;
struct SideW { int first, stride, issued, consumed, hist; };
constexpr int SIDE_NITEMS = 32 * 16 * 32;
__device__ __forceinline__ LAS unsigned char* side_ring(LAS unsigned char* lds, int wid) { return lds + 81920 + wid * 4096; }
__device__ __forceinline__ LAS unsigned* side_stg(LAS unsigned char* lds, int wid) { return (LAS unsigned*)(lds + (wid < 4 ? 114688 + wid * 4352 : 141312 + (wid - 4) * 4352)); }
__device__ __forceinline__ bool side_issue(SideW& s, const float* wsrc, LAS unsigned char* lds, int wid, int lane) {
    asm volatile("" : "+v"(lane));
    const int it = s.first + (s.issued >> 4) * s.stride, p = s.issued & 15;
    if (it >= SIDE_NITEMS) return false;
    const int kb = it & 15, nb = (it >> 4) & 31, e = it >> 9;
    const float* src = wsrc + (size_t)e * 1024 * 2048 + (size_t)(kb * 64 + 4 * p + (lane >> 4)) * 2048 + nb * 64 + 4 * (lane & 15);
    __builtin_amdgcn_global_load_lds((const unsigned*)src, (LAS unsigned*)(side_ring(lds, wid) + (s.issued & 3) * 1024), 16, 0, 0);
    s.issued += 1; return true;
}
__device__ __forceinline__ void side_burst(int it, unsigned char* wdst, LAS unsigned char* lds, int wid, int lane) {
    asm volatile("" : "+v"(lane));
    const LAS unsigned* stg = side_stg(lds, wid);
    const int kb = it & 15, nb = (it >> 4) & 31, e = it >> 9, j0 = (nb & 15) * 64, ndst = (j0 >> 7) * 256 + (j0 & 127) + ((nb >> 4) ? 128 : 0), rr = lane >> 2, c = lane & 3;
#pragma unroll
    for (int jj = 0; jj < 4; ++jj) { const int n = rr + 16 * jj; u32x4 o; o.x = stg[n * 17 + 4 * c]; o.y = stg[n * 17 + 4 * c + 1]; o.z = stg[n * 17 + 4 * c + 2]; o.w = stg[n * 17 + 4 * c + 3];
        *(u32x4*)(wdst + (size_t)e * 2048 * 1024 + (size_t)(ndst + n) * 1024 + kb * 64 + 16 * c) = o; }
}
__device__ __forceinline__ void side_consume(SideW& s, unsigned char* wdst, LAS unsigned char* lds, int wid, int lane) {
    asm volatile("" : "+v"(lane));
    const int p = s.consumed & 15; const LAS float* r = (const LAS float*)(side_ring(lds, wid) + (s.consumed & 3) * 1024) + lane;
    const float f0 = r[0], f1 = r[64], f2 = r[128], f3 = r[192];
    side_stg(lds, wid)[lane * 17 + p] = pk4_fp8(clamp_fp8(f0 * W8_SCALE), clamp_fp8(f1 * W8_SCALE), clamp_fp8(f2 * W8_SCALE), clamp_fp8(f3 * W8_SCALE));
    s.consumed += 1;
    if (p == 15) side_burst(s.first + ((s.consumed - 1) >> 4) * s.stride, wdst, lds, wid, lane);
}
__device__ __forceinline__ int side_step(SideW& s, const float* wsrc, unsigned char* wdst, LAS unsigned char* lds, int wid, int lane) {
    if (s.hist & 4) side_consume(s, wdst, lds, wid, lane);
    const int now = side_issue(s, wsrc, lds, wid, lane) ? 1 : 0;
    s.hist = ((s.hist << 1) | now) & 7; return now;
}
#define VM_WAIT(n_) do { switch (n_) { case 0: asm volatile("s_waitcnt vmcnt(0)" ::: "memory"); break; case 1: asm volatile("s_waitcnt vmcnt(1)" ::: "memory"); break; case 2: asm volatile("s_waitcnt vmcnt(2)" ::: "memory"); break; \
        case 3: asm volatile("s_waitcnt vmcnt(3)" ::: "memory"); break; case 4: asm volatile("s_waitcnt vmcnt(4)" ::: "memory"); break; case 5: asm volatile("s_waitcnt vmcnt(5)" ::: "memory"); break; \
        case 6: asm volatile("s_waitcnt vmcnt(6)" ::: "memory"); break; case 7: asm volatile("s_waitcnt vmcnt(7)" ::: "memory"); break; default: asm volatile("s_waitcnt vmcnt(8)" ::: "memory"); break; } } while (0)
__device__ __forceinline__ void attn_unit(LAS unsigned char* lds, int b, int h, int qb, const bf16_t* q, const bf16_t* kk, const bf16_t* kr, const bf16_t* vt, bf16_t* ymix, SideW& sw, const float* wsrc, unsigned char* wdst) {
    const int tid = threadIdx.x, lane = tid & 63, wid = __builtin_amdgcn_readfirstlane(tid >> 6), fr = lane & 15, fq = lane >> 4;
    const int NT = 8 * qb + 8;
    int key[4] = {wid * 4, (7 - wid) * 4 + 1, ((wid + 4) & 7) * 4 + 2, (7 - ((wid + 4) & 7)) * 4 + 3};
#define ATT_CSWAP(i_, j_) do { const int lo_ = key[i_] < key[j_] ? key[i_] : key[j_], hi_ = key[i_] < key[j_] ? key[j_] : key[i_]; key[i_] = hi_; key[j_] = lo_; } while (0)
    ATT_CSWAP(0, 1); ATT_CSWAP(2, 3); ATT_CSWAP(0, 2); ATT_CSWAP(1, 3); ATT_CSWAP(1, 2);
#undef ATT_CSWAP
    int lastq[ATT_NQ]; unsigned rowq[ATT_NQ];
#pragma unroll
    for (int qk = 0; qk < ATT_NQ; ++qk) { const int ch = __builtin_amdgcn_readfirstlane(key[qk] >> 2), role = __builtin_amdgcn_readfirstlane(key[qk] & 3);
        lastq[qk] = 8 * qb + ch; rowq[qk] = (unsigned)(b * SEQ + qb * 512 + ch * 64 + role * 16); }
    bf16x8 qf[ATT_NQ][3];
#pragma unroll
    for (int qk = 0; qk < ATT_NQ; ++qk) { const bf16_t* qr = q + (size_t)(rowq[qk] + fr) * 768;
        qf[qk][0] = *(const bf16x8*)(qr + h * 64 + fq * 8); qf[qk][1] = *(const bf16x8*)(qr + h * 64 + 32 + fq * 8); qf[qk][2] = *(const bf16x8*)(qr + 512 + h * 32 + fq * 8); }
    const int sb = lane * 16, swz = sb ^ (((sb >> 9) & 1) << 5), rr = swz >> 6, cc = (swz & 63) >> 1;
    const int foff = (fr * 64 + fq * 16) ^ ((((fr * 64 + fq * 16) >> 9) & 1) << 5);
    const int i0 = wid, i1 = 8 + (wid & 3);
    const int p0 = ((i0 % 3) == 2) ? 32 : 512, p1 = ((i1 % 3) == 2) ? 32 : 512;
    const bf16_t* ksrc0 = ((i0 % 3) == 2) ? kr + ((size_t)(b * SEQ + (i0 / 3) * 16 + rr) * 32 + cc) : kk + ((size_t)(b * SEQ + (i0 / 3) * 16 + rr) * 512 + h * 64 + (i0 % 3) * 32 + cc);
    const bf16_t* ksrc1 = ((i1 % 3) == 2) ? kr + ((size_t)(b * SEQ + (i1 / 3) * 16 + rr) * 32 + cc) : kk + ((size_t)(b * SEQ + (i1 / 3) * 16 + rr) * 512 + h * 64 + (i1 % 3) * 32 + cc);
    const bf16_t* vsrc = vt + ((size_t)((b * 8 + h) * 64) * 4096 + ((wid >> 1) * 16 + rr) * 64 + (wid & 1) * 32 + cc);
#define ATT_DMA(t, buf) do { \
        __builtin_amdgcn_global_load_lds((const unsigned*)(ksrc0 + (size_t)(t) * 64 * p0), (LAS unsigned*)(lds + (buf) * ATT_KB + i0 * 1024), 16, 0, 0); \
        if (wid < 4) __builtin_amdgcn_global_load_lds((const unsigned*)(ksrc1 + (size_t)(t) * 64 * p1), (LAS unsigned*)(lds + (buf) * ATT_KB + i1 * 1024), 16, 0, 0); \
        __builtin_amdgcn_global_load_lds((const unsigned*)(vsrc + (size_t)(t) * 4096), (LAS unsigned*)(lds + ATT_V0 + (buf) * ATT_VB + wid * 1024), 16, 0, 0); } while (0)
    f32x4 O[4][ATT_NQ], L[ATT_NQ];
#pragma unroll
    for (int qk = 0; qk < ATT_NQ; ++qk) { L[qk] = (f32x4){0.f, 0.f, 0.f, 0.f};
#pragma unroll
        for (int d = 0; d < 4; ++d) O[d][qk] = (f32x4){0.f, 0.f, 0.f, 0.f}; }
    float mrun[ATT_NQ], lchk[ATT_NQ];
#pragma unroll
    for (int qk = 0; qk < ATT_NQ; ++qk) { mrun[qk] = 0.f; lchk[qk] = 1.f; }
    const bf16x8 ones = {0x3F80, 0x3F80, 0x3F80, 0x3F80, 0x3F80, 0x3F80, 0x3F80, 0x3F80};
#define ATT_TILE(NA_) do { \
            const LAS unsigned char* kb = lds + (t & 3) * ATT_KB + foff; const LAS unsigned char* vb = lds + ATT_V0 + (t & 3) * ATT_VB + foff; \
              \
            _Pragma("unroll") for (int qk = 0; qk < NA_; ++qk) { const float lv = lchk[qk]; \
                if (__any(lv > 0x1p40f || (t > 1 && lv < 0x1p-40f))) { \
                    const bool need = lv > 0x1p40f || (t > 1 && lv < 0x1p-40f); \
                    const float d = need ? (lv < 0x1p-120f ? -100.f : floorf(__builtin_amdgcn_logf(lv))) : 0.f, sc = __builtin_amdgcn_exp2f(-d); \
                    mrun[qk] += d; L[qk] = L[qk] * sc; \
                    _Pragma("unroll") for (int dd = 0; dd < 4; ++dd) O[dd][qk] = O[dd][qk] * sc; } } \
            f32x4 S[4][NA_]; \
            _Pragma("unroll") for (int kv = 0; kv < 4; ++kv) \
                _Pragma("unroll") for (int qk = 0; qk < NA_; ++qk) { const float nm = -mrun[qk]; S[kv][qk] = (f32x4){nm, nm, nm, nm}; } \
            _Pragma("unroll") for (int st = 0; st < 3; ++st) \
                _Pragma("unroll") for (int kv = 0; kv < 4; ++kv) { const bf16x8 a = *(const LAS bf16x8*)(kb + (kv * 3 + st) * 1024); \
                    _Pragma("unroll") for (int qk = 0; qk < NA_; ++qk) S[kv][qk] = __builtin_amdgcn_mfma_f32_16x16x32_bf16(a, qf[qk][st], S[kv][qk], 0, 0, 0); } \
            bf16x8 pf[NA_][2]; \
            _Pragma("unroll") for (int qk = 0; qk < NA_; ++qk) { \
                _Pragma("unroll") for (int kv = 0; kv < 4; ++kv) \
                    _Pragma("unroll") for (int i = 0; i < 4; ++i) S[kv][qk][i] = __builtin_amdgcn_exp2f(S[kv][qk][i]); \
                _Pragma("unroll") for (int s2 = 0; s2 < 2; ++s2) { u32x4 w; w.x = pk2(S[2 * s2][qk][0], S[2 * s2][qk][1]); w.y = pk2(S[2 * s2][qk][2], S[2 * s2][qk][3]); w.z = pk2(S[2 * s2 + 1][qk][0], S[2 * s2 + 1][qk][1]); w.w = pk2(S[2 * s2 + 1][qk][2], S[2 * s2 + 1][qk][3]); \
                    pf[qk][s2] = __builtin_bit_cast(bf16x8, w); } } \
            _Pragma("unroll") for (int qk = 0; qk < NA_; ++qk) lchk[qk] = L[qk][0]; \
            _Pragma("unroll") for (int s2 = 0; s2 < 2; ++s2) { \
                _Pragma("unroll") for (int d = 0; d < 4; ++d) { const bf16x8 a = *(const LAS bf16x8*)(vb + (d * 2 + s2) * 1024); \
                    _Pragma("unroll") for (int qk = 0; qk < NA_; ++qk) O[d][qk] = __builtin_amdgcn_mfma_f32_16x16x32_bf16(a, pf[qk][s2], O[d][qk], 0, 0, 0); } \
                _Pragma("unroll") for (int qk = 0; qk < NA_; ++qk) L[qk] = __builtin_amdgcn_mfma_f32_16x16x32_bf16(ones, pf[qk][s2], L[qk], 0, 0, 0); } } while (0)
    ATT_DMA(0, 0); ATT_DMA(1, 1); ATT_DMA(2, 2);
#define ATT_SYNC() do { VM_WAIT(c1 + c2); \
        __builtin_amdgcn_s_barrier(); asm volatile("" ::: "memory"); \
        int now_ = 0; if (t + 3 < NT) { ATT_DMA(t + 3, (t + 3) & 3); now_ = PW; } \
        c2 = c1; c1 = now_; } while (0)
#define ATT_SIDE() do { c1 += side_step(sw, wsrc, wdst, lds, wid, lane); } while (0)
    const int PW = (wid < 4) ? 3 : 2;
#pragma unroll
    for (int qk = 0; qk < ATT_NQ; ++qk) asm volatile("" : "+v"(qf[qk][0]), "+v"(qf[qk][1]), "+v"(qf[qk][2]));
    int c1 = PW, c2 = PW;
    int t = 0;
    for (; t <= lastq[3]; ++t) { ATT_SYNC(); ATT_TILE(4); ATT_SIDE(); }
    for (; t <= lastq[2]; ++t) { ATT_SYNC(); ATT_TILE(3); ATT_SIDE(); }
    for (; t <= lastq[1]; ++t) { ATT_SYNC(); ATT_TILE(2); ATT_SIDE(); }
    for (; t <= lastq[0]; ++t) { ATT_SYNC(); ATT_TILE(1); ATT_SIDE(); }
    for (; t < NT; ++t) { ATT_SYNC(); ATT_SIDE(); }
#undef ATT_SYNC
#undef ATT_SIDE
#undef ATT_TILE
#undef ATT_DMA
#pragma unroll
    for (int qk = 0; qk < ATT_NQ; ++qk) { const float il = 1.f / L[qk][0];
        bf16_t* op = ymix + (size_t)(rowq[qk] + fr) * 1024 + 512 + h * 64 + 4 * fq;
#pragma unroll
        for (int d = 0; d < 4; ++d) st_bf16x4(op + d * 16, O[d][qk] * il); }
    asm volatile("s_waitcnt lgkmcnt(0)" ::: "memory"); __builtin_amdgcn_s_barrier(); asm volatile("" ::: "memory");
}
__device__ __forceinline__ void attn_mfma(const Frame& F, const Args& args) {
    unsigned char* ws = args.ws; const bf16_t* q = (const bf16_t*)(ws + WS_Q); const bf16_t* kk = (const bf16_t*)(ws + WS_KK); const bf16_t* kr = (const bf16_t*)(ws + WS_KR); const bf16_t* vt = (const bf16_t*)(ws + WS_V); bf16_t* ymix = (bf16_t*)(ws + WS_YMIX);
    SideW sw; sw.first = F.bid * NWAVES + F.wave; sw.stride = F.G * NWAVES; sw.issued = 0; sw.consumed = 0; sw.hist = 0;
    const float* wsrc = IN_F(23); unsigned char* wdst = ws + WS_WGU_T;
    for (int c = F.vcu; c < 512; c += F.G) { const int bh = c >> 2, pr = c & 3;
        attn_unit(F.lds, bh >> 3, bh & 7, pr, q, kk, kr, vt, ymix, sw, wsrc, wdst); attn_unit(F.lds, bh >> 3, bh & 7, 7 - pr, q, kk, kr, vt, ymix, sw, wsrc, wdst); }
    asm volatile("s_waitcnt vmcnt(0)" ::: "memory");
    while (sw.consumed < sw.issued) side_consume(sw, wdst, F.lds, F.wave, F.lane);
    while ((sw.issued & 15) != 0) { int n = 0;
        while (n < 4 && (sw.issued & 15) != 0) { side_issue(sw, wsrc, F.lds, F.wave, F.lane); ++n; }
        asm volatile("s_waitcnt vmcnt(0)" ::: "memory");
        while (sw.consumed < sw.issued) side_consume(sw, wdst, F.lds, F.wave, F.lane); }
    asm volatile("s_waitcnt lgkmcnt(0)" ::: "memory");
    for (int it = sw.first + (sw.issued >> 4) * sw.stride; it < SIDE_NITEMS; it += sw.stride) { const int kb = it & 15, nb = (it >> 4) & 31, e = it >> 9; const int j0 = (nb & 15) * 64;
        tr8_item(IN_F(23) + (size_t)e * 1024 * 2048, 2048, 1024, ws + WS_WGU_T + (size_t)e * 2048 * 1024, nb * 64, (j0 >> 7) * 256 + (j0 & 127) + ((nb >> 4) ? 128 : 0), kb * 64, side_stg(F.lds, F.wave), F.lane); }
}

__device__ __forceinline__ void ph7_mixpost(const Frame& F, const Args& args) {
    const bf16_t* ymix = (const bf16_t*)(args.ws + WS_YMIX); unsigned char* ymix8 = args.ws + WS_YMIX8;
    for (int q = 0; ; ++q) { const int pm_ = F.vcu + (q >> 2) * F.G; if (pm_ >= NTOK / 256) break; const int m0 = 256 * pm_ + (q & 3) * 64 + F.wave * 8;
        u32x4 v[8]; float ss[8];
#pragma unroll
        for (int r = 0; r < 8; ++r) v[r] = *(const u32x4*)(ymix + (size_t)(m0 + r) * 1024 + 512 + 8 * F.lane);
#pragma unroll
        for (int r = 0; r < 8; ++r) { const f32x4 a = bf_lo4(v[r]), b2 = bf_hi4(v[r]); ss[r] = a[0] * a[0] + a[1] * a[1] + a[2] * a[2] + a[3] * a[3] + b2[0] * b2[0] + b2[1] * b2[1] + b2[2] * b2[2] + b2[3] * b2[3]; }
#pragma unroll
        for (int o = 1; o < 64; o <<= 1) {
#pragma unroll
            for (int r = 0; r < 8; ++r) ss[r] += __shfl_xor(ss[r], o); }
#pragma unroll
        for (int r = 0; r < 8; ++r) { const float rstd = 1.f / sqrtf(ss[r] * (1.f / 512.f) + NORM_EPS); const f32x4 a = bf_lo4(v[r]) * rstd, b2 = bf_hi4(v[r]) * rstd;
            u32x2 o; o.x = pk4_fp8(clamp_fp8(a[0]), clamp_fp8(a[1]), clamp_fp8(a[2]), clamp_fp8(a[3])); o.y = pk4_fp8(clamp_fp8(b2[0]), clamp_fp8(b2[1]), clamp_fp8(b2[2]), clamp_fp8(b2[3]));
            *(u32x2*)(ymix8 + (size_t)(m0 + r) * 1024 + 512 + 8 * F.lane) = o; }
    }
}

__device__ __forceinline__ void ph9_rowpass(const Frame& F, const Args& args) {
    unsigned char* ws = args.ws; const float* x = IN_F(0); const bf16_t* mix = (const bf16_t*)(ws + WS_MIX); const float* mod = (const float*)(ws + WS_MOD);
    const float* g_post = IN_F(19); const float* g_pre = IN_F(20); unsigned char* h2q = ws + WS_H2Q; bf16_t* x1b = (bf16_t*)(ws + WS_X1B);
    float* logits = (float*)(ws + WS_LOGITS); const float* rbias = IN_F(22);
    { const bf16_t* wrt = (const bf16_t*)(ws + WS_WR_T);
      for (int ch = F.tid; ch < 4096; ch += NTHR) { const int r = ch >> 7, c8 = (ch & 127) * 8;
          *(LAS u32x4*)(F.lds + (c8 >> 6) * 4096 + pg8::lds_byte(r, c8 & 63)) = *(const u32x4*)(wrt + (size_t)r * 1024 + c8); }
      __syncthreads(); }
    constexpr int R9 = 4;
    LAS unsigned char* hb = F.lds + 65536 + F.wave * 8704;
    const int fr = F.lane & 15, fq = F.lane >> 4;
    const int foff = (fr * 64 + fq * 16) ^ ((((fr * 64 + fq * 16) >> 9) & 1) << 5);
    const f32x4 rb0 = *(const f32x4*)(rbias + 4 * fq), rb1 = *(const f32x4*)(rbias + 16 + 4 * fq);
    for (int q = 0; ; ++q) { const int pm_ = F.vcu + (q >> 3) * F.G; if (pm_ >= NTOK / 256) break; const int m0 = 256 * pm_ + (q & 7) * (NWAVES * R9) + F.wave * R9;
        const int b = m0 >> 12; const float* mb = mod + b * 6144; f32x4 mv[R9][4], xv[R9][4]; float ss[R9], ss2[R9];
#pragma unroll
        for (int r = 0; r < R9; ++r)
#pragma unroll
            for (int j = 0; j < 4; ++j) { { const u32x2 w2 = __builtin_nontemporal_load((const u32x2*)(mix + (size_t)(m0 + r) * DM + 4 * F.lane + 256 * j)); mv[r][j] = (f32x4){__uint_as_float(w2.x << 16), __uint_as_float(w2.x & 0xffff0000u), __uint_as_float(w2.y << 16), __uint_as_float(w2.y & 0xffff0000u)}; } xv[r][j] = __builtin_nontemporal_load((const f32x4*)(x + (size_t)(m0 + r) * DM + 4 * F.lane + 256 * j)); }
#pragma unroll
        for (int r = 0; r < R9; ++r) { float t = 0.f;
#pragma unroll
            for (int j = 0; j < 4; ++j) t += mv[r][j][0] * mv[r][j][0] + mv[r][j][1] * mv[r][j][1] + mv[r][j][2] * mv[r][j][2] + mv[r][j][3] * mv[r][j][3];
            ss[r] = t; }
#pragma unroll
        for (int o = 1; o < 64; o <<= 1) {
#pragma unroll
            for (int r = 0; r < R9; ++r) ss[r] += __shfl_xor(ss[r], o); }
#pragma unroll
        for (int r = 0; r < R9; ++r) { const float rstd = 1.f / sqrtf(ss[r] * (1.f / DM) + NORM_EPS); float t = 0.f;
#pragma unroll
            for (int j = 0; j < 4; ++j) { const int col = 4 * F.lane + 256 * j; xv[r][j] = xv[r][j] + *(const f32x4*)(mb + 2048 + col) * (mv[r][j] * rstd * *(const f32x4*)(g_post + col));
                { u32x2 w2; w2.x = pk2(xv[r][j][0], xv[r][j][1]); w2.y = pk2(xv[r][j][2], xv[r][j][3]); __builtin_nontemporal_store(w2, (u32x2*)(x1b + (size_t)(m0 + r) * DM + col)); } t += xv[r][j][0] * xv[r][j][0] + xv[r][j][1] * xv[r][j][1] + xv[r][j][2] * xv[r][j][2] + xv[r][j][3] * xv[r][j][3]; }
            ss2[r] = t; }
#pragma unroll
        for (int o = 1; o < 64; o <<= 1) {
#pragma unroll
            for (int r = 0; r < R9; ++r) ss2[r] += __shfl_xor(ss2[r], o); }
#pragma unroll
        for (int r = 0; r < R9; ++r) { const float rstd2 = 1.f / sqrtf(ss2[r] * (1.f / DM) + NORM_EPS);
#pragma unroll
            for (int j = 0; j < 4; ++j) { const int col = 4 * F.lane + 256 * j;
                const f32x4 hv = xv[r][j] * rstd2 * *(const f32x4*)(g_pre + col) * (*(const f32x4*)(mb + 4096 + col) + 1.f) + *(const f32x4*)(mb + 3072 + col);
                { u32x2 w2; w2.x = pk2(hv[0], hv[1]); w2.y = pk2(hv[2], hv[3]); *(LAS u32x2*)(hb + r * 2112 + col * 2) = w2; }
                *(unsigned*)(h2q + (size_t)(m0 + r) * DM + col) = pk4_fp8(clamp_fp8(hv[0]), clamp_fp8(hv[1]), clamp_fp8(hv[2]), clamp_fp8(hv[3])); } }
        f32x4 ra[2][2];
#pragma unroll
        for (int e = 0; e < 2; ++e) { ra[e][0] = (f32x4){0.f, 0.f, 0.f, 0.f}; ra[e][1] = ra[e][0]; }
        const LAS unsigned char* hrow = hb + (fr & (R9 - 1)) * 2112 + fq * 16;
#pragma unroll 4
        for (int kt = 0; kt < 16; ++kt) {
#pragma unroll
            for (int kh = 0; kh < 2; ++kh) { const bf16x8 hf = *(const LAS bf16x8*)(hrow + kt * 128 + kh * 64);
#pragma unroll
                for (int e = 0; e < 2; ++e) { const bf16x8 wf = *(const LAS bf16x8*)(F.lds + kt * 4096 + (e * 2 + kh) * 1024 + foff);
                    ra[e][kh] = __builtin_amdgcn_mfma_f32_16x16x32_bf16(wf, hf, ra[e][kh], 0, 0, 0); } } }
        if (fr < R9) { float* lp = logits + (size_t)(m0 + fr) * 32 + 4 * fq;
            *(f32x4*)lp = ra[0][0] + ra[0][1] + rb0; *(f32x4*)(lp + 16) = ra[1][0] + ra[1][1] + rb1; }
    }
    __syncthreads();
}

__device__ __forceinline__ void ph11_topk(const Frame& F, const Args& args) {
    unsigned char* ws = args.ws; const float* logits = (const float*)(ws + WS_LOGITS); unsigned* cnt = (unsigned*)(ws + WS_CTL) + CW_CNT;
    int* tope = (int*)(ws + WS_TOPE); float* topg = (float*)(ws + WS_TOPG); int* topr = (int*)(ws + WS_TOPR);
    int* slot_tok = (int*)(ws + WS_SLOT_TOK); int* slot_y = (int*)(ws + WS_SLOT_Y); float* slot_g = (float*)(ws + WS_SLOT_G);
    for (int i = gtid(F); i < NSLOT; i += F.G * NTHR) { slot_tok[i] = 0; slot_y[i] = -1; slot_g[i] = 0.f; }
    LAS unsigned* hist = (LAS unsigned*)F.lds; LAS unsigned* base = hist + 32;
    for (int pm_ = F.vcu; pm_ < NTOK / 256; pm_ += F.G) { const bool act = F.tid < 256;
        if (F.tid < 32) hist[F.tid] = 0u;
        __syncthreads();
        const int tok = 256 * pm_ + (F.tid & 255); float lv[32];
#pragma unroll
        for (int j = 0; j < 8; ++j) { const f32x4 t = *(const f32x4*)(logits + (size_t)tok * 32 + 4 * j); lv[4 * j] = t[0]; lv[4 * j + 1] = t[1]; lv[4 * j + 2] = t[2]; lv[4 * j + 3] = t[3]; }
        int ei[4]; float ev[4];
#pragma unroll
        for (int k = 0; k < 4; ++k) { float best = -INFINITY; int bi = 0;
#pragma unroll
            for (int e = 0; e < 32; ++e) { if (lv[e] > best) { best = lv[e]; bi = e; } }
            ei[k] = bi; ev[k] = best;
#pragma unroll
            for (int e = 0; e < 32; ++e) { if (e == bi) lv[e] = -INFINITY; } }
        float gs = 0.f, gv[4];
#pragma unroll
        for (int k = 0; k < 4; ++k) { gv[k] = __expf(ev[k] - ev[0]); gs += gv[k]; }
        int lr[4];
#pragma unroll
        for (int k = 0; k < 4; ++k) lr[k] = act ? (int)atomicAdd((unsigned*)&hist[ei[k]], 1u) : 0;
        __syncthreads();
        if (F.tid < 32) base[F.tid] = atomicAdd(&cnt[F.tid], (unsigned)hist[F.tid]);
        __syncthreads();
        if (act) {
#pragma unroll
        for (int k = 0; k < 4; ++k) { tope[(size_t)tok * 4 + k] = ei[k]; topg[(size_t)tok * 4 + k] = gv[k] / gs; topr[(size_t)tok * 4 + k] = (int)base[ei[k]] + lr[k]; } }
        __syncthreads();
    }
}
__device__ __forceinline__ void moe_tables(const Frame& F, const Args& args, LAS int* pstart, LAS int* pend) {
    const unsigned* cnt = (const unsigned*)(args.ws + WS_CTL) + CW_CNT;
    if (F.tid < 64) {
        const int e = F.tid & 31; const int c = (int)__hip_atomic_load(cnt + e, __ATOMIC_RELAXED, __HIP_MEMORY_SCOPE_AGENT);
        const int padded = ((c + 255) / 256) * 256; int run = padded;
#pragma unroll
        for (int off = 1; off < 32; off <<= 1) { const int t = __shfl_up(run, off); if ((F.tid & 31) >= off) run += t; }
        if (F.tid < 32) { pstart[e] = run - padded; pend[e] = run; }
    }
    __syncthreads();
    const int npanel = pend[NEXP - 1] / 256;
    for (int p = F.tid; p < npanel; p += NTHR) { int e = 0; while (e < NEXP - 1 && pend[e] <= p * 256) ++e; pend[32 + p] = e; }
    __syncthreads();
}
__device__ __forceinline__ void ph12_slots(const Frame& F, const Args& args) {
    unsigned char* ws = args.ws; LAS int* pstart = (LAS int*)(F.lds + MISC_OFF + 64); LAS int* pend = pstart + 32;
    moe_tables(F, args, pstart, pend);
    const int* tope = (const int*)(ws + WS_TOPE); const float* topg = (const float*)(ws + WS_TOPG); const int* topr = (const int*)(ws + WS_TOPR);
    int* slot_tok = (int*)(ws + WS_SLOT_TOK); int* slot_y = (int*)(ws + WS_SLOT_Y); float* slot_g = (float*)(ws + WS_SLOT_G);
    for (int i = gtid(F); i < NTOK * 4; i += F.G * NTHR) { const int dest = pstart[tope[i]] + topr[i]; slot_tok[dest] = i >> 2; slot_y[dest] = i; slot_g[dest] = topg[i]; }
}

__device__ __forceinline__ void ph14_final(const Frame& F, const Args& args) {
    unsigned char* ws = args.ws; const unsigned char* y4 = ws + WS_Y4; const bf16_t* x1b = (const bf16_t*)(ws + WS_X1B); const float* mod = (const float*)(ws + WS_MOD); const float* gain = IN_F(27); float* out = args.out;
    for (int m0 = (F.bid * NWAVES + F.wave) * 2; m0 < NTOK; m0 += F.G * NWAVES * 2) {
        const int b = m0 >> 12; f32x4 f[2][4], xo[2][4]; float ss[2];
#pragma unroll
        for (int r = 0; r < 2; ++r)
#pragma unroll
            for (int j = 0; j < 4; ++j) { const int col = 4 * F.lane + 256 * j; const unsigned char* yp = y4 + ((size_t)(m0 + r) * 4) * DM + col;
                f[r][j] = (ld_fp8x4(yp) + ld_fp8x4(yp + DM)) + (ld_fp8x4(yp + 2 * DM) + ld_fp8x4(yp + 3 * DM)); { const u32x2 w2 = __builtin_nontemporal_load((const u32x2*)(x1b + (size_t)(m0 + r) * DM + col)); xo[r][j] = (f32x4){__uint_as_float(w2.x << 16), __uint_as_float(w2.x & 0xffff0000u), __uint_as_float(w2.y << 16), __uint_as_float(w2.y & 0xffff0000u)}; } }
#pragma unroll
        for (int r = 0; r < 2; ++r) { float t = 0.f;
#pragma unroll
            for (int j = 0; j < 4; ++j) t += f[r][j][0] * f[r][j][0] + f[r][j][1] * f[r][j][1] + f[r][j][2] * f[r][j][2] + f[r][j][3] * f[r][j][3];
            ss[r] = t; }
#pragma unroll
        for (int o = 1; o < 64; o <<= 1) { ss[0] += __shfl_xor(ss[0], o); ss[1] += __shfl_xor(ss[1], o); }
#pragma unroll
        for (int r = 0; r < 2; ++r) { const float rstd = 1.f / sqrtf(ss[r] * (1.f / DM) + NORM_EPS);
#pragma unroll
            for (int j = 0; j < 4; ++j) { const int col = 4 * F.lane + 256 * j;
                __builtin_nontemporal_store(xo[r][j] + *(const f32x4*)(mod + b * 6144 + 5120 + col) * (f[r][j] * rstd * *(const f32x4*)(gain + col)), (f32x4*)(out + (size_t)(m0 + r) * DM + col)); } }
    }
}

typedef const __attribute__((address_space(4))) unsigned long long* karg_p;
__device__ __forceinline__ void load_args(Args& a) {
    karg_p kp = (karg_p)__builtin_amdgcn_kernarg_segment_ptr();
    asm volatile("" : "+s"(kp));
#pragma unroll
    for (int i = 0; i < 28; ++i) a.in[i] = (const void*)(GAS const void*)kp[i];
    a.out = (float*)(GAS float*)kp[28]; a.ws = (unsigned char*)(GAS unsigned char*)kp[29]; a.ph_lo = 0; a.ph_hi = 0; a.li = 0; a.pad = 0;
}
#define PH_BEGIN Args args; load_args(args); unsigned char* ws = args.ws; (void)ws
constexpr int N_PHASES = 15;
__global__ void __launch_bounds__(NTHR, 2) fwd(Args kargs) {
    extern __shared__ __attribute__((aligned(16))) unsigned char lds_raw[];
    Frame F; F.lds = (LAS unsigned char*)lds_raw; F.tid = threadIdx.x; F.lane = F.tid & 63; F.wave = __builtin_amdgcn_readfirstlane(F.tid >> 6); F.G = gridDim.x; F.bid = blockIdx.x; F.a = nullptr; F.vcu = (F.G % 8 == 0) ? (F.bid % 8) * (F.G / 8) + F.bid / 8 : F.bid;
    volatile LAS unsigned* MISC = (volatile LAS unsigned*)(F.lds + MISC_OFF);
    if (F.tid < 16) MISC[F.tid] = 0u;
    __syncthreads();
    XcdBarrier bar = xcd_barrier_post((unsigned*)(kargs.ws + WS_CTL) + CW_BAR + kargs.li * XCD_BAR_WORDS, MISC);
    const int lo = kargs.ph_lo, hi = kargs.ph_hi;
#ifndef PHASE_MASK
#define PHASE_MASK 0xffffffffu
#endif
#define IN(k) (((PHASE_MASK >> (k)) & 1u) && lo <= (k) && (k) < hi)
#ifndef REPEAT_MASK
#define REPEAT_MASK 0u
#endif
#define REP(k) for (int rep_ = 0; rep_ < ((((REPEAT_MASK) >> (k)) & 1u) ? 2 : 1); ++rep_)
#define SEAM(k) do { if (IN(k) && IN((k) + 1)) xcd_barrier(bar); } while (0)

    if (IN(0)) REP(0) { PH_BEGIN; ph0_prep(F, args); } SEAM(0);
    if (IN(1)) REP(1) { PH_BEGIN; ph1_h1(F, args); } SEAM(1);
    if (IN(2)) REP(2) { PH_BEGIN;
        Gemm g{(const bf16_t*)(ws + WS_H1), 1024, (const bf16_t*)(ws + WS_WIN_T), 1024, nullptr}; DenseOrder S; S.init(NTOK, PROJ_LD, F.G, F.vcu);
        EpiStoreBf16S E{(bf16_t*)(ws + WS_PROJ), PROJ_LD, W8_INV}; GEMM_PHASE_F8(F.lds, g, S, E);
    } SEAM(2);
    if (IN(3)) REP(3) { PH_BEGIN; ph3_tokprep(F, args); } SEAM(3);
    if (IN(4)) REP(4) { PH_BEGIN;
        { Gemm g{(const bf16_t*)(ws + WS_PROJ) + PC_QA, PROJ_LD, (const bf16_t*)(ws + WS_WQ_T), 384, nullptr}; DenseOrder S; S.init(NTOK, 768, F.G, F.vcu);
          EpiQ E{(bf16_t*)(ws + WS_Q), (const float*)(ws + WS_RSTDQ), (const float*)(ws + WS_COS), (const float*)(ws + WS_SIN), F.lds}; GEMM_PHASE(F.lds, g, S, E); }
        { Gemm g{(const bf16_t*)(ws + WS_PROJ) + PC_KVA, PROJ_LD, (const bf16_t*)(ws + WS_WKV_T), 256, nullptr}; DenseOrder S; S.init(NTOK, 512, F.G, F.vcu);
          EpiK E{(bf16_t*)(ws + WS_KK), (const float*)(ws + WS_RSTDKV), F.lds}; GEMM_PHASE(F.lds, g, S, E); }
        { Gemm g{(const bf16_t*)(ws + WS_PROJ) + PC_KVA, PROJ_LD, (const bf16_t*)(ws + WS_WKV_T) + 512 * 256, 256, nullptr}; DenseOrder S; S.init(NTOK, 512, F.G, F.vcu);
          EpiVT E{(bf16_t*)(ws + WS_V), (const float*)(ws + WS_RSTDKV), F.lds}; GEMM_PHASE_SWAP(F.lds, g, S, E); }
        ssd_phase_a(F, args);
    } SEAM(4);
    if (IN(5)) REP(5) { PH_BEGIN; ssd_phase_b(F, args); attn_mfma(F, args); } SEAM(5);
    if (IN(6)) REP(6) { PH_BEGIN; ssd_phase_c(F, args); ph7_mixpost(F, args); }
#define LOCAL_SEAM() do { asm volatile("s_waitcnt vmcnt(0)" ::: "memory"); __builtin_amdgcn_fence(__ATOMIC_RELEASE, "workgroup"); __syncthreads(); __builtin_amdgcn_fence(__ATOMIC_ACQUIRE, "workgroup"); } while (0)
    if (IN(6) && IN(8)) xcd_barrier(bar);
    const bool conv_first = ((F.bid >> 3) & 1) != 0;
    if (IN(8)) REP(8) { PH_BEGIN;
        if (conv_first) { ph_moe_weights(F, args); __syncthreads(); }
        Gemm g{(const bf16_t*)(ws + WS_YMIX8), 1024, (const bf16_t*)(ws + WS_WOUT_T), 1024, nullptr}; DenseOrder S; S.init(NTOK, 1024, F.G, F.vcu, 1);
        EpiStoreBf16S E{(bf16_t*)(ws + WS_MIX), 1024, W8_INV}; GEMM_PHASE_F8(F.lds, g, S, E);
    } if (IN(8) && IN(9)) LOCAL_SEAM();
    if (IN(9)) REP(9) { PH_BEGIN; ph9_rowpass(F, args); if (!conv_first) ph_moe_weights(F, args); } if (IN(9) && IN(11)) LOCAL_SEAM();
    if (IN(11)) REP(11) { PH_BEGIN; ph11_topk(F, args); } SEAM(11);
    if (IN(12)) REP(12) { PH_BEGIN; ph12_slots(F, args); } SEAM(12);
    if (IN(13)) REP(13) { PH_BEGIN;
        LAS int* pstart = (LAS int*)(F.lds + MISC_OFF + 64); LAS int* pend = pstart + 32;
        if (!IN(12)) moe_tables(F, args, pstart, pend);
        const int npanel = pend[NEXP - 1] / 256;
        { Gemm g{(const bf16_t*)(ws + WS_H2Q), 1024, (const bf16_t*)(ws + WS_WGU_T), 1024, (const int*)(ws + WS_SLOT_TOK)};
          MoeOrder S{8, npanel * 8, F.G, F.vcu, 0, 0, pend}; EpiGU E{ws + WS_ACT, IN_F(24), 0, F.lds}; GEMM_PHASE_F8G(F.lds, g, S, E); }
        xcd_barrier(bar);
        { Gemm g{(const bf16_t*)(ws + WS_ACT), 1024, (const bf16_t*)(ws + WS_WDN_T), 1024, nullptr};
          MoeOrder S{4, npanel * 4, F.G, F.vcu, 0, 0, pend}; EpiDown E{ws + WS_Y4, IN_F(26), (const int*)(ws + WS_SLOT_Y), (const float*)(ws + WS_SLOT_G), F.lds}; GEMM_PHASE_F8(F.lds, g, S, E); }
        xcd_barrier(bar);
    }
    if (IN(14)) REP(14) { PH_BEGIN; ph14_final(F, args); }
#undef IN
#undef SEAM
}

extern "C" void kernel_launch(void* const* d_in, const int* in_sizes, int n_in, void* d_out, int out_size, void* d_ws, size_t ws_size, hipStream_t stream) {
    static int grid = 0;
    if (grid == 0) {
        if (n_in != 28 || out_size != NTOK * DM || ws_size < WS_END) { fprintf(stderr, "kernel_launch: unexpected shapes n_in %d out %d ws %zu\n", n_in, out_size, ws_size); grid = -1; return; }
        int dev = 0, cus = 0, per_cu = 0;
        if (hipGetDevice(&dev) != hipSuccess || hipDeviceGetAttribute(&cus, hipDeviceAttributeMultiprocessorCount, dev) != hipSuccess) { grid = -1; return; }
        if (hipFuncSetAttribute((const void*)fwd, hipFuncAttributeMaxDynamicSharedMemorySize, LDS_BYTES) != hipSuccess) { fprintf(stderr, "kernel_launch: hipFuncSetAttribute failed\n"); grid = -1; return; }
        if (hipOccupancyMaxActiveBlocksPerMultiprocessor(&per_cu, (const void*)fwd, NTHR, LDS_BYTES) != hipSuccess || per_cu < 1) fprintf(stderr, "kernel_launch: occupancy query says %d\n", per_cu);
        (void)hipGetLastError();
        grid = cus;
    }
    if (grid < 0) return;
    (void)hipMemsetAsync((char*)d_ws + WS_CTL, 0, CTL_ZERO_BYTES, stream);
    Args a{};
    for (int i = 0; i < 28; ++i) a.in[i] = d_in[i];
    a.out = (float*)d_out; a.ws = (unsigned char*)d_ws;
#if N_LAUNCH_MODE == 1
    a.ph_lo = 0; a.ph_hi = N_PHASES; a.li = 0;
    hipLaunchKernelGGL(fwd, dim3(grid), dim3(NTHR), LDS_BYTES, stream, a);
#else
    for (int p = 0; p < N_PHASES; ++p) {
        a.ph_lo = p; a.ph_hi = p + 1; a.li = p;
        hipLaunchKernelGGL(fwd, dim3(grid), dim3(NTHR), LDS_BYTES, stream, a);
    }
#endif
}
```

```cpp
#include <hip/hip_runtime.h>
#include <cstdio>
#include <cstdint>

#ifndef N_LAUNCH_MODE
#define N_LAUNCH_MODE 1
#endif

#define GAS __attribute__((address_space(1)))
#define LAS __attribute__((address_space(3)))
typedef unsigned short bf16_t;
typedef float f32x4 __attribute__((ext_vector_type(4)));
typedef float f32x2 __attribute__((ext_vector_type(2)));
typedef unsigned u32x4 __attribute__((ext_vector_type(4)));
typedef unsigned u32x2 __attribute__((ext_vector_type(2)));
typedef short bf16x8 __attribute__((ext_vector_type(8)));

constexpr int BATCH = 16, SEQ = 4096, DM = 1024, NTOK = BATCH * SEQ;
constexpr int CHUNK = 64, NCHUNK = SEQ / CHUNK;
constexpr int SSD_INNER = 512, SSD_HEADS = 8, SSD_P = 64, SSD_N = 128, XBC_DIM = 1024;
constexpr int MLA_H = 8, Q_LORA = 384, KV_LORA = 256;
constexpr int IN_COLS = 2216, PROJ_LD = 2304;
constexpr int PC_Z = 0, PC_XBC = 512, PC_QA = 1536, PC_KVA = 1920, PC_KR = 2176, PC_DT = 2208;
constexpr int NEXP = 32, TOPK = 4, FF = 1024;
constexpr int NSLOT = (NTOK * TOPK / 256 + NEXP) * 256;
constexpr int ACT_ROWS = NSLOT;
constexpr float NORM_EPS = 1e-6f;
constexpr int NWAVES = 8, NTHR = 512;

constexpr size_t MiB = 1u << 20;
constexpr size_t WS_CTL = 0, CTL_ZERO_BYTES = 1 * MiB;
constexpr size_t WS_MOD = 1 * MiB;
constexpr size_t WS_COS = 2 * MiB, WS_SIN = 6 * MiB;
constexpr size_t WS_DT = 10 * MiB;
constexpr size_t WS_RSTDQ = 12 * MiB, WS_RSTDKV = 12 * MiB + 512 * 1024;
constexpr size_t WS_LOGITS = 13 * MiB;
constexpr size_t WS_TOPE = 21 * MiB, WS_TOPG = 22 * MiB, WS_TOPR = 23 * MiB;
constexpr size_t WS_SLOT_TOK = 24 * MiB, WS_SLOT_Y = 26 * MiB, WS_SLOT_G = 28 * MiB;
constexpr size_t WS_WQ_T = 30 * MiB, WS_WKV_T = 31 * MiB, WS_WR_T = 31 * MiB + 512 * 1024, WS_WOUT_T = 32 * MiB, WS_WIN_T = 34 * MiB;
constexpr size_t WS_PROJ = 40 * MiB;
constexpr size_t WS_XBC = 328 * MiB;
constexpr size_t WS_H1 = 456 * MiB;
constexpr size_t WS_Q = 584 * MiB;
constexpr size_t WS_KK = 680 * MiB;
constexpr size_t WS_V = 744 * MiB;
constexpr size_t WS_YMIX = 808 * MiB;
constexpr size_t WS_KR = 13 * MiB;
constexpr size_t WS_MIX = 40 * MiB;
constexpr size_t WS_ACT = 40 * MiB;
constexpr size_t WS_H2 = 168 * MiB;
constexpr size_t WS_WGU_T = 936 * MiB;
constexpr size_t WS_WDN_T = 368 * MiB;
constexpr size_t WS_H2Q = 400 * MiB;
constexpr size_t WS_X1B = 744 * MiB;
constexpr size_t WS_Y4 = 488 * MiB;
constexpr size_t WS_END = 1000 * MiB;

constexpr int CW_BAR = 4096;
constexpr int CW_CNT = 131072;

constexpr int LDS_BYTES = 163840;
constexpr int MISC_OFF = 135168;

__device__ __forceinline__ float bf2f(bf16_t b) { return __uint_as_float(((unsigned)b) << 16); }
__device__ __forceinline__ unsigned f2bf(float f) { unsigned u = __float_as_uint(f); return (u + 0x7fffu + ((u >> 16) & 1u)) >> 16; }
typedef __bf16 bf16x2_t __attribute__((ext_vector_type(2)));
__device__ __forceinline__ unsigned pk2(float lo, float hi) { const f32x2 v = {lo, hi}; const bf16x2_t b = __builtin_convertvector(v, bf16x2_t); return __builtin_bit_cast(unsigned, b); }
__device__ __forceinline__ float wave_sum(float v) {
#pragma unroll
    for (int o = 1; o < 64; o <<= 1) v += __shfl_xor(v, o);
    return v;
}
__device__ __forceinline__ void st_bf16x4(bf16_t* p, f32x4 v) { u32x2 w; w.x = pk2(v[0], v[1]); w.y = pk2(v[2], v[3]); *(u32x2*)p = w; }
__device__ __forceinline__ f32x4 ld_bf16x4(const bf16_t* p) { const u32x2 w = *(const u32x2*)p; f32x4 r; r[0] = __uint_as_float(w.x << 16); r[1] = __uint_as_float(w.x & 0xffff0000u); r[2] = __uint_as_float(w.y << 16); r[3] = __uint_as_float(w.y & 0xffff0000u); return r; }
__device__ __forceinline__ float clamp_fp8(float v) { return __builtin_amdgcn_fmed3f(v, -448.f, 448.f); }
__device__ __forceinline__ unsigned pk4_fp8(float a, float b, float c, float d) { int w; asm("" : "=v"(w));
    w = __builtin_amdgcn_cvt_pk_fp8_f32(a, b, w, false); w = __builtin_amdgcn_cvt_pk_fp8_f32(c, d, w, true); return (unsigned)w; }
typedef float f32x2v __attribute__((ext_vector_type(2)));
__device__ __forceinline__ f32x4 ld_fp8x4(const unsigned char* p) { const int w = __builtin_nontemporal_load((const int*)p); const f32x2v lo = __builtin_amdgcn_cvt_pk_f32_fp8(w, false), hi = __builtin_amdgcn_cvt_pk_f32_fp8(w, true); return (f32x4){lo[0], lo[1], hi[0], hi[1]}; }
__device__ __forceinline__ float silu_f(float v) { return v / (1.f + __expf(-v)); }

#define XB_TMO      128
#define XB_XCNT(j)  (256  + 64 * (j))
#define XB_XSUB(j)  (1280 + 64 * (j))
#define XB_XGEN(j)  (2304 + 64 * (j))
#define XB_TOP      3328
#define XB_TOPGEN   3392
#define XCD_BAR_WORDS 3456
#define XB_SPIN_CAP (1u << 21)

__device__ __forceinline__ unsigned xb_ld(unsigned* p)              { return __hip_atomic_load(p, __ATOMIC_RELAXED, __HIP_MEMORY_SCOPE_AGENT); }
__device__ __forceinline__ unsigned xb_add(unsigned* p, unsigned v) { return __hip_atomic_fetch_add(p, v, __ATOMIC_RELAXED, __HIP_MEMORY_SCOPE_AGENT); }
__device__ __forceinline__ unsigned xb_xcc_id() { return (unsigned)__builtin_amdgcn_s_getreg((3 << 11) | 20) & 0xFu; }
#define XB_SPIN(cond, bar) do { unsigned _sp = 0; while (cond) { __builtin_amdgcn_s_sleep(1); \
    if ((++_sp & 255u) == 0u) { if (xb_ld(&(bar)[XB_TMO])) break; if (_sp > XB_SPIN_CAP) { atomicAdd(&(bar)[XB_TMO], 1u); break; } } } } while (0)

struct XcdBarrier { unsigned* bar; unsigned x; volatile LAS unsigned* st; };

__device__ __forceinline__ XcdBarrier xcd_barrier_post(unsigned* bar, volatile LAS unsigned* st) {
    XcdBarrier b; b.bar = bar; b.x = xb_xcc_id(); b.st = st;
    if (threadIdx.x == 0) (void)xb_add(&bar[XB_XCNT(b.x)], 1u);
    return b;
}
__device__ __forceinline__ void xcd_barrier_complete(unsigned* bar, unsigned x, unsigned& nloc, unsigned& nx) {
    const unsigned G = gridDim.x * gridDim.y * gridDim.z;
    unsigned sum, cnt, mine, sp = 0u;
    for (;;) {
        sum = 0u; cnt = 0u; mine = 0u;
#pragma unroll
        for (unsigned j = 0; j < 16; ++j) { const unsigned c = xb_ld(&bar[XB_XCNT(j)]); sum += c; cnt += (c > 0u) ? 1u : 0u; mine = (j == x) ? c : mine; }
        if (sum == G) break;
        __builtin_amdgcn_s_sleep(1);
        if ((++sp & 255u) == 0u) { if (xb_ld(&bar[XB_TMO])) break; if (sp > XB_SPIN_CAP) { atomicAdd(&bar[XB_TMO], 1u); break; } }
    }
    nloc = mine > 0u ? mine : 1u; nx = cnt > 0u ? cnt : 1u;
}
__device__ __forceinline__ void xcd_barrier(const XcdBarrier& b) {
    asm volatile("s_waitcnt vmcnt(0)" ::: "memory");
    __syncthreads();
    if (threadIdx.x == 0) {
        unsigned* bar = b.bar;
        __builtin_amdgcn_s_waitcnt(0);
        unsigned nloc = b.st[0], nx = b.st[1];
        if (nloc == 0u) { xcd_barrier_complete(bar, b.x, nloc, nx); b.st[0] = nloc; b.st[1] = nx; }
        const unsigned old = xb_add(&bar[XB_XSUB(b.x)], 1u);
        const unsigned gen = old / nloc;
        if (old + 1u == (gen + 1u) * nloc) {
            __builtin_amdgcn_fence(__ATOMIC_RELEASE, "agent");
            asm volatile("s_waitcnt vmcnt(0)" ::: "memory");
            const unsigned og = xb_add(&bar[XB_TOP], 1u);
            const unsigned tg = og / nx;
            if (og + 1u == (tg + 1u) * nx) xb_add(&bar[XB_TOPGEN], 1u);
            else XB_SPIN(xb_ld(&bar[XB_TOPGEN]) == tg, bar);
            __builtin_amdgcn_fence(__ATOMIC_ACQUIRE, "agent");
            xb_add(&bar[XB_XGEN(b.x)], 1u);
            asm volatile("s_waitcnt vmcnt(0)" ::: "memory");
        } else {
            XB_SPIN(xb_ld(&bar[XB_XGEN(b.x)]) == gen, bar);
            __builtin_amdgcn_fence(__ATOMIC_ACQUIRE, "agent");
            asm volatile("s_waitcnt vmcnt(0)" ::: "memory");
        }
    }
    __syncthreads();
}

struct Args { const void* in[28]; float* out; unsigned char* ws; int ph_lo, ph_hi, li, pad; };

struct Frame {
    LAS unsigned char* lds;
    int tid, lane, wave, G, bid, vcu;
    const Args* a;
};
__device__ __forceinline__ int gtid(const Frame& F) { int t = F.tid; asm volatile("" : "+v"(t)); return F.bid * NTHR + t; }
#define IN_F(i) ((const float*)args.in[i])
#define IN_I(i) ((const int*)args.in[i])

struct Unit { int arow0; int brow0; int pm; int pn; int e; int ui; };
struct Gemm { const bf16_t* A; int lda; const bf16_t* Bt; int K; const int* gather; };

struct DenseOrder {
    int nN, nunits, G, c, owner;
    __device__ __forceinline__ void init(int M, int N, int G_, int c_, int owner_ = 0) { nN = N / 256; nunits = (M / 256) * nN; G = G_; c = c_; owner = owner_; }
    __device__ __forceinline__ bool next(int i, Unit& u) const {
        const int L = owner ? ((i / nN) * G + c) * nN + i % nN : i * G + c; if (L >= nunits) return false;
        u.pm = L / nN; u.pn = L % nN; u.arow0 = u.pm * 256; u.brow0 = u.pn * 256; u.e = 0; u.ui = i; return true;
    }
};
struct MoeOrder {
    int nN, nunits, G, c, p0, e0; const LAS int* pend;
    __device__ __forceinline__ bool next(int i, Unit& u) const {
        const int L = i * G + c; if (L >= nunits) return false;
        const int panel = p0 + L / nN; u.pn = L % nN; u.pm = panel; u.arow0 = panel * 256;
        const int e = pend[32 + panel];
        u.e = e; u.brow0 = (e * nN + u.pn) * 256; u.ui = i; return true;
    }
};

__device__ __forceinline__ void st_bf16x8(bf16_t* p, f32x4 a, f32x4 b) { u32x4 w; w.x = pk2(a[0], a[1]); w.y = pk2(a[2], a[3]); w.z = pk2(b[0], b[1]); w.w = pk2(b[2], b[3]); *(u32x4*)p = w; }
struct EpiStoreBf16 {
    static constexpr int NSTORES = 16; static constexpr bool PERM = true;
    bf16_t* O; int ldc;
    __device__ __forceinline__ void operator()(const f32x4 (&acc)[2][2][4][2], const Unit& u, int wr, int wc, int fr, int fq) const {
#pragma unroll
        for (int ai = 0; ai < 2; ++ai)
#pragma unroll
            for (int m = 0; m < 4; ++m) { const unsigned row = (unsigned)(u.pm * 256 + ai * 128 + wr * 64 + m * 16 + fr); bf16_t* rp = O + ((size_t)row * (unsigned)ldc + (unsigned)(u.pn * 256 + wc * 32 + 8 * fq));
#pragma unroll
                for (int bj = 0; bj < 2; ++bj) st_bf16x8(rp + bj * 128, acc[ai][bj][m][0], acc[ai][bj][m][1]); }
    }
};
struct EpiStoreBf16S {
    static constexpr int NSTORES = 16; static constexpr bool PERM = true;
    bf16_t* O; int ldc; float scale;
    __device__ __forceinline__ void operator()(const f32x4 (&acc)[2][2][4][2], const Unit& u, int wr, int wc, int fr, int fq) const {
#pragma unroll
        for (int ai = 0; ai < 2; ++ai)
#pragma unroll
            for (int m = 0; m < 4; ++m) { const unsigned row = (unsigned)(u.pm * 256 + ai * 128 + wr * 64 + m * 16 + fr); bf16_t* rp = O + ((size_t)row * (unsigned)ldc + (unsigned)(u.pn * 256 + wc * 32 + 8 * fq));
#pragma unroll
                for (int bj = 0; bj < 2; ++bj) st_bf16x8(rp + bj * 128, acc[ai][bj][m][0] * scale, acc[ai][bj][m][1] * scale); }
    }
};
struct EpiQ {
    static constexpr int NSTORES = 32; static constexpr bool PERM = false;
    bf16_t* q; const float* rstd; const float* cs; const float* sn;
    LAS unsigned char* lds;
    static constexpr int RS_LDS = 141312;
    __device__ __forceinline__ void prefetch(const Unit& u, int lane, int wid) const {
        if (wid == 0) __builtin_amdgcn_global_load_lds((const unsigned*)(rstd + u.pm * 256 + 4 * lane), (LAS unsigned*)(lds + RS_LDS + (u.ui % 3) * 1024), 16, 0, 0);
    }
    __device__ __forceinline__ void operator()(const f32x4 (&acc)[2][2][4][2], const Unit& u, int wr, int wc, int fr, int fq) const {
        const bool rope = (u.pn == 2);
        float rsv[2][4];
#pragma unroll
        for (int ai = 0; ai < 2; ++ai)
#pragma unroll
            for (int m = 0; m < 4; ++m) rsv[ai][m] = ((const LAS float*)(lds + RS_LDS + (u.ui % 3) * 1024))[ai * 128 + wr * 64 + m * 16 + fr];
#pragma unroll
        for (int ai = 0; ai < 2; ++ai) {
            f32x4 c4m[4], s4m[4];
#pragma unroll
            for (int m = 0; m < 4; ++m) { c4m[m] = (f32x4){1.f, 1.f, 1.f, 1.f}; s4m[m] = (f32x4){0.f, 0.f, 0.f, 0.f}; }
            if (rope) {
#pragma unroll
                for (int m = 0; m < 4; ++m) { const unsigned row = (unsigned)(u.pm * 256 + ai * 128 + wr * 64 + m * 16 + fr); c4m[m] = *(const f32x4*)(cs + (row * 16u + 4u * fq)); s4m[m] = *(const f32x4*)(sn + (row * 16u + 4u * fq)); } }
#pragma unroll
            for (int m = 0; m < 4; ++m) { const unsigned row = (unsigned)(u.pm * 256 + ai * 128 + wr * 64 + m * 16 + fr); const float rs = rsv[ai][m];
                bf16_t* rp = q + (row * 768u + (unsigned)(u.pn * 256 + wc * 32 + 4 * fq));
                const f32x4 c4 = c4m[m], s4 = s4m[m];
#pragma unroll
                for (int bj = 0; bj < 2; ++bj) { const f32x4 x1 = acc[ai][bj][m][0] * rs, x2 = acc[ai][bj][m][1] * rs;
                    st_bf16x4(rp + bj * 128, x1 * c4 - x2 * s4); st_bf16x4(rp + bj * 128 + 16, x2 * c4 + x1 * s4); }
                asm volatile("" ::: "memory"); } }
    }
};
struct EpiK {
    static constexpr int NSTORES = 16; static constexpr bool PERM = true;
    bf16_t* kk; const float* rstd;
    LAS unsigned char* lds;
    static constexpr int RS_LDS = 141312;
    __device__ __forceinline__ void prefetch(const Unit& u, int lane, int wid) const {
        if (wid == 0) __builtin_amdgcn_global_load_lds((const unsigned*)(rstd + u.pm * 256 + 4 * lane), (LAS unsigned*)(lds + RS_LDS + (u.ui % 3) * 1024), 16, 0, 0);
    }
    __device__ __forceinline__ void operator()(const f32x4 (&acc)[2][2][4][2], const Unit& u, int wr, int wc, int fr, int fq) const {
        float rsv[2][4];
#pragma unroll
        for (int ai = 0; ai < 2; ++ai)
#pragma unroll
            for (int m = 0; m < 4; ++m) rsv[ai][m] = ((const LAS float*)(lds + RS_LDS + (u.ui % 3) * 1024))[ai * 128 + wr * 64 + m * 16 + fr];
#pragma unroll
        for (int ai = 0; ai < 2; ++ai)
#pragma unroll
            for (int m = 0; m < 4; ++m) { const unsigned row = (unsigned)(u.pm * 256 + ai * 128 + wr * 64 + m * 16 + fr); const float rs = rsv[ai][m];
                bf16_t* rp = kk + (row * 512u + (unsigned)(u.pn * 256 + wc * 32 + 8 * fq));
#pragma unroll
                for (int bj = 0; bj < 2; ++bj) st_bf16x8(rp + bj * 128, acc[ai][bj][m][0] * rs, acc[ai][bj][m][1] * rs);
                asm volatile("" ::: "memory"); }
    }
};
struct EpiVT {
    static constexpr int NSTORES = 32; static constexpr bool PERM = false;
    bf16_t* vt; const float* rstd;
    LAS unsigned char* lds;
    static constexpr int RS_LDS = 141312;
    __device__ __forceinline__ void prefetch(const Unit& u, int lane, int wid) const {
        if (wid == 0) __builtin_amdgcn_global_load_lds((const unsigned*)(rstd + u.pm * 256 + 4 * lane), (LAS unsigned*)(lds + RS_LDS + (u.ui % 3) * 1024), 16, 0, 0);
    }
    __device__ __forceinline__ void operator()(const f32x4 (&acc)[2][2][4][2], const Unit& u, int wr, int wc, int fr, int fq) const {
        f32x4 rsv[2][4];
#pragma unroll
        for (int ai = 0; ai < 2; ++ai)
#pragma unroll
            for (int m = 0; m < 4; ++m) rsv[ai][m] = *(const LAS f32x4*)((const LAS float*)(lds + RS_LDS + (u.ui % 3) * 1024) + ai * 128 + wr * 64 + m * 16 + 4 * fq);
#pragma unroll
        for (int ai = 0; ai < 2; ++ai) { const unsigned row0 = (unsigned)(u.pm * 256 + ai * 128 + wr * 64); const unsigned b = row0 >> 12, chunk = (row0 & 4095u) >> 6;
#pragma unroll
            for (int m = 0; m < 4; ++m) { const f32x4 rs = rsv[ai][m]; const unsigned pos = (unsigned)(32 * (m >> 1) + 8 * fq + 4 * (m & 1));
#pragma unroll
                for (int bj = 0; bj < 2; ++bj)
#pragma unroll
                    for (int n = 0; n < 2; ++n) { const unsigned c = (unsigned)(u.pn * 256 + bj * 128 + wc * 32 + n * 16 + fr), h = c >> 6, d = c & 63u;
                        st_bf16x4(vt + ((((b * 8u + h) * 64u + chunk) * 64u + d) * 64u + pos), acc[ai][bj][m][n] * rs); }
                asm volatile("" ::: "memory"); } }
    }
};
struct EpiRouter {
    static constexpr int NSTORES = 0; static constexpr bool PERM = false;
    float* logits; const float* bias;
    __device__ __forceinline__ void operator()(const f32x4 (&acc)[2][2][4][2], const Unit& u, int wr, int wc, int fr, int fq) const {
        if (wc != 0) return;
#pragma unroll
        for (int ai = 0; ai < 2; ++ai)
#pragma unroll
            for (int m = 0; m < 4; ++m) { const int row = u.pm * 256 + ai * 128 + wr * 64 + m * 16 + fr;
#pragma unroll
                for (int n = 0; n < 2; ++n) { const int c = n * 16 + 4 * fq; *(f32x4*)(logits + (size_t)row * 32 + c) = acc[ai][0][m][n] + *(const f32x4*)(bias + c); } }
    }
};
constexpr float W8_SCALE = 32.f, W8_INV = 1.f / 32.f;
struct EpiGU {
    static constexpr int NSTORES = 8; static constexpr bool PERM = true;
    unsigned char* act; const float* bias; int base; LAS unsigned char* lds;
    static constexpr int BIAS_LDS = 141312;
    __device__ __forceinline__ void prefetch(const Unit& u, int lane, int wid) const {
        if (wid != 0) return;
        const float* src = bias + (size_t)u.e * 2048 + u.pn * 128 + (lane < 32 ? 4 * lane : 1024 + 4 * (lane - 32));
        __builtin_amdgcn_global_load_lds((const unsigned*)src, (LAS unsigned*)(lds + BIAS_LDS + (u.ui & 1) * 1024), 16, 0, 0);
    }
    __device__ __forceinline__ void init_acc(f32x4 (&acc)[2][2][4][2], const Unit& u, int wc, int fq, bool from_lds) const {
        f32x4 bg[2], bl[2];
        if (from_lds) { const LAS float* bq = (const LAS float*)(lds + BIAS_LDS + (u.ui & 1) * 1024) + wc * 32 + 8 * fq;
#pragma unroll
            for (int n = 0; n < 2; ++n) { bg[n] = *(const LAS f32x4*)(bq + 4 * n); bl[n] = *(const LAS f32x4*)(bq + 128 + 4 * n); } }
        else { const float* be = bias + (size_t)u.e * 2048 + u.pn * 128 + wc * 32 + 8 * fq;
#pragma unroll
            for (int n = 0; n < 2; ++n) { bg[n] = *(const f32x4*)(be + 4 * n); bl[n] = *(const f32x4*)(be + 1024 + 4 * n); } }
#pragma unroll
        for (int n = 0; n < 2; ++n) { bg[n] = bg[n] * 32.f; bl[n] = (bl[n] + 1.f) * 32.f; }
#pragma unroll
        for (int ai = 0; ai < 2; ++ai)
#pragma unroll
            for (int m = 0; m < 4; ++m)
#pragma unroll
                for (int n = 0; n < 2; ++n) { acc[ai][0][m][n] = bg[n]; acc[ai][1][m][n] = bl[n]; }
    }
    __device__ __forceinline__ void operator()(const f32x4 (&acc)[2][2][4][2], const Unit& u, int wr, int wc, int fr, int fq) const {
        const int j = u.pn * 128 + wc * 32 + 8 * fq;
#pragma unroll
        for (int ai = 0; ai < 2; ++ai)
#pragma unroll
            for (int m = 0; m < 4; ++m) { const int arow = u.arow0 - base + ai * 128 + wr * 64 + m * 16 + fr; u32x2 w;
#pragma unroll
                for (int n = 0; n < 2; ++n) { const f32x4 g4 = acc[ai][0][m][n], l4 = acc[ai][1][m][n]; f32x2 o[2];
#pragma unroll
                    for (int h = 0; h < 2; ++h) {
                        const f32x2 g = {__builtin_amdgcn_fmed3f(g4[2 * h], -3.0e38f, 7.f * 32.f), __builtin_amdgcn_fmed3f(g4[2 * h + 1], -3.0e38f, 7.f * 32.f)};
                        const f32x2 l = {__builtin_amdgcn_fmed3f(l4[2 * h], -6.f * 32.f, 8.f * 32.f), __builtin_amdgcn_fmed3f(l4[2 * h + 1], -6.f * 32.f, 8.f * 32.f)};
                        const f32x2 e = g * (-1.702f * 1.4426950408889634f / 32.f);
                        f32x2 d = {__builtin_amdgcn_exp2f(e[0]), __builtin_amdgcn_exp2f(e[1])}; d = d * 1024.f + 1024.f;
                        const f32x2 r = {__builtin_amdgcn_rcpf(d[0]), __builtin_amdgcn_rcpf(d[1])};
                        o[h] = (g * r) * l; }
                    w[n] = pk4_fp8(o[0][0], o[0][1], o[1][0], o[1][1]); }
                *(u32x2*)(act + ((unsigned)arow * 1024u + (unsigned)j)) = w; }
    }
};
struct EpiDown {
    static constexpr int NSTORES = 16; static constexpr bool PERM = true;
    unsigned char* y4; const float* bias; const int* slot_y; const float* slot_g; LAS unsigned char* lds;
    static constexpr int BIAS_LDS = 141312;
    __device__ __forceinline__ void prefetch(const Unit& u, int lane, int wid) const {
        LAS unsigned char* buf = lds + BIAS_LDS + (u.ui % 3) * 3072;
        if (wid == 0) __builtin_amdgcn_global_load_lds((const unsigned*)(bias + (size_t)u.e * 1024 + u.pn * 256 + 4 * lane), (LAS unsigned*)buf, 16, 0, 0);
        else if (wid == 1) __builtin_amdgcn_global_load_lds((const unsigned*)(slot_y + u.arow0 + 4 * lane), (LAS unsigned*)(buf + 1024), 16, 0, 0);
        else if (wid == 2) __builtin_amdgcn_global_load_lds((const unsigned*)(slot_g + u.arow0 + 4 * lane), (LAS unsigned*)(buf + 2048), 16, 0, 0);
    }
    __device__ __forceinline__ void init_acc(f32x4 (&acc)[2][2][4][2], const Unit& u, int wc, int fq, bool from_lds) const {
        f32x4 bv[2][2];
        if (from_lds) {
            const unsigned ba = (unsigned)(size_t)(lds + BIAS_LDS + (u.ui % 3) * 3072) + (unsigned)(wc * 32 + 8 * fq) * 4u;
            asm volatile("ds_read_b128 %0, %4\n\tds_read_b128 %1, %4 offset:16\n\tds_read_b128 %2, %4 offset:512\n\tds_read_b128 %3, %4 offset:528\n\ts_waitcnt lgkmcnt(0)"
                         : "=&v"(bv[0][0]), "=&v"(bv[0][1]), "=&v"(bv[1][0]), "=&v"(bv[1][1]) : "v"(ba) : "memory"); }
        else { const float* be = bias + (size_t)u.e * 1024 + u.pn * 256 + wc * 32 + 8 * fq;
#pragma unroll
            for (int bj = 0; bj < 2; ++bj)
#pragma unroll
                for (int n = 0; n < 2; ++n) bv[bj][n] = *(const f32x4*)(be + bj * 128 + 4 * n); }
#pragma unroll
        for (int ai = 0; ai < 2; ++ai)
#pragma unroll
            for (int bj = 0; bj < 2; ++bj)
#pragma unroll
                for (int m = 0; m < 4; ++m)
#pragma unroll
                    for (int n = 0; n < 2; ++n) acc[ai][bj][m][n] = bv[bj][n] * 32.f;
    }
    __device__ __forceinline__ void operator()(const f32x4 (&acc)[2][2][4][2], const Unit& u, int wr, int wc, int fr, int fq) const {
        const int d0 = u.pn * 256 + wc * 32 + 8 * fq;
        int yrv[2][4]; float gv[2][4];
        { const unsigned ya = (unsigned)(size_t)(lds + BIAS_LDS + (u.ui % 3) * 3072 + 1024) + (unsigned)(wr * 64 + fr) * 4u;
#pragma unroll
            for (int ai = 0; ai < 2; ++ai)
#pragma unroll
                for (int m = 0; m < 4; ++m) asm volatile("ds_read_b32 %0, %2 offset:%3\n\tds_read_b32 %1, %2 offset:%4" : "=&v"(yrv[ai][m]), "=&v"(gv[ai][m]) : "v"(ya), "n"((ai * 128 + m * 16) * 4), "n"((ai * 128 + m * 16) * 4 + 1024) : "memory");
            asm volatile("s_waitcnt lgkmcnt(0)" ::: "memory");
#pragma unroll
            for (int ai = 0; ai < 2; ++ai)
#pragma unroll
                for (int m = 0; m < 4; ++m) asm volatile("" : "+v"(yrv[ai][m]), "+v"(gv[ai][m])); }
#pragma unroll
        for (int ai = 0; ai < 2; ++ai)
#pragma unroll
            for (int m = 0; m < 4; ++m) { const int yr = yrv[ai][m]; const float sg = gv[ai][m] * W8_INV;
                { unsigned char* rp = y4 + ((ptrdiff_t)yr * 1024 + d0);
#pragma unroll
                    for (int bj = 0; bj < 2; ++bj) { const f32x4 a = acc[ai][bj][m][0] * sg, b2 = acc[ai][bj][m][1] * sg;
                        u32x2 w; w.x = pk4_fp8(a[0], a[1], a[2], a[3]); w.y = pk4_fp8(b2[0], b2[1], b2[2], b2[3]); *(u32x2*)(rp + bj * 128) = w; } } }
    }
};

template <class T, class = void> struct epi_has_prefetch { static constexpr bool value = false; };
template <class T> struct epi_has_prefetch<T, decltype((void)&T::prefetch)> { static constexpr bool value = true; };
template <class T, class = void> struct epi_has_fold { static constexpr bool value = false; };
template <class T> struct epi_has_fold<T, decltype((void)&T::init_acc)> { static constexpr bool value = true; };
static_assert(epi_has_fold<EpiGU>::value && epi_has_fold<EpiDown>::value && !epi_has_fold<EpiStoreBf16S>::value, "fold detection");
namespace pg8 {
constexpr int BK = 64, HALF = 128, HTB = HALF * BK * 2, STAGE_BYTES = 8 * HTB;
__device__ __forceinline__ int lds_byte(int r, int c) { const int st = (r >> 4) * 2 + (c >> 5), rr = r & 15, cc = c & 31, ob = rr * 64 + cc * 2; return st * 1024 + (ob ^ (((ob >> 9) & 1) << 5)); }
__device__ __forceinline__ void stage_rc(int b, int& R, int& C) { const int st = b / 1024, sb = b % 1024, swz = sb ^ (((sb >> 9) & 1) << 5); R = (st >> 1) * 16 + swz / 64; C = (st & 1) * 32 + (swz % 64) / 2; }

typedef int i32x4 __attribute__((ext_vector_type(4)));
typedef int i32x8 __attribute__((ext_vector_type(8)));
__device__ __forceinline__ int perm32(int rho) { const int n = rho >> 4, i = rho & 15; return 8 * (i >> 2) + 4 * n + (i & 3); }
template <class Epi, class Sched, bool GATHER, bool ALIGN_EPI, bool SWAP = false, bool FP8 = false>
__device__ __forceinline__ void gemm_phase_mfma(LAS unsigned char* lds, const Gemm g, const Sched& S, const Epi& E) {
    const int tid = threadIdx.x, wid = __builtin_amdgcn_readfirstlane(tid >> 6), lane = tid & 63, wr = wid >> 2, wc = wid & 3, fr = lane & 15, fq = lane >> 4;
    constexpr int ESZ = FP8 ? 1 : 2; const int K = g.K, nt = (K * ESZ) / (BK * 2); const unsigned lda2 = (unsigned)g.lda * (unsigned)ESZ; const unsigned rowB = (unsigned)K * (unsigned)ESZ;
    int sR[2], sC[2];
    unsigned voffB[2], cvA[2][2]; int nidx[2][2];
#pragma unroll
    for (int i = 0; i < 2; ++i) { stage_rc(tid * 16 + i * 8192, sR[i], sC[i]); const int rB = Epi::PERM ? ((sR[i] & ~31) + perm32(sR[i] & 31)) : sR[i]; voffB[i] = (unsigned)rB * rowB + (unsigned)sC[i] * 2u; }
    const size_t kstep = (size_t)(BK * 2);
    const size_t hstepB = (size_t)HALF * rowB;
    const unsigned ldsw = (unsigned)wid * 1024u;
    const int aoff = lds_byte(wr * 64 + fr, fq * 8), boff = lds_byte(wc * 32 + fr, fq * 8);
    const int rmask = ((nt & (nt - 1)) == 0) ? (nt - 1) : 0; const int wrapmask = rmask ? rmask : 0x7fffffff;
#define PG8_ROT(u) (((u).pn + 2 * ((u).pm & 3)) & rmask)
#define PG8_KO(t, r) ((size_t)(((t) + (r)) & wrapmask) * kstep)
#define PG8_SA(b, h) (((b) * 2 + (h)) * HTB)
#define PG8_SB(b, h) ((4 + (b) * 2 + (h)) * HTB)
#define PG8_STAGE(bufoff, gbase, voff) do { _Pragma("unroll") for (int _i = 0; _i < 2; ++_i) \
        __builtin_amdgcn_global_load_lds((const unsigned*)((const char*)(gbase) + (voff)[_i]), (LAS unsigned*)(lds + (bufoff) + ldsw + _i * 8192), 16, 0, 0); } while (0)
#define PG8_LDA(dst, b, h) do { _Pragma("unroll") for (int m = 0; m < 4; ++m) { if constexpr (FP8) { const i32x4 lo_ = *(const LAS i32x4*)(lds + PG8_SA(b, h) + aoff + m * 2048), hi_ = *(const LAS i32x4*)(lds + PG8_SA(b, h) + aoff + m * 2048 + 1024); dst##8[m] = __builtin_shufflevector(lo_, hi_, 0, 1, 2, 3, 4, 5, 6, 7); } \
        else { _Pragma("unroll") for (int k = 0; k < 2; ++k) dst[m][k] = *(const LAS bf16x8*)(lds + PG8_SA(b, h) + aoff + m * 2048 + k * 1024); } } } while (0)
#define PG8_LDB(dst, b, h) do { _Pragma("unroll") for (int n = 0; n < 2; ++n) { if constexpr (FP8) { const i32x4 lo_ = *(const LAS i32x4*)(lds + PG8_SB(b, h) + boff + n * 2048), hi_ = *(const LAS i32x4*)(lds + PG8_SB(b, h) + boff + n * 2048 + 1024); dst##8[n] = __builtin_shufflevector(lo_, hi_, 0, 1, 2, 3, 4, 5, 6, 7); } \
        else { _Pragma("unroll") for (int k = 0; k < 2; ++k) dst[n][k] = *(const LAS bf16x8*)(lds + PG8_SB(b, h) + boff + n * 2048 + k * 1024); } } } while (0)
#define PG8_MMA(ai, bj, At, Bt) do { __builtin_amdgcn_s_setprio(1); _Pragma("unroll") for (int m = 0; m < 4; ++m) _Pragma("unroll") for (int n = 0; n < 2; ++n) { \
        if constexpr (FP8) { asm volatile("v_mfma_f32_16x16x128_f8f6f4 %0, %1, %2, %0" : "+v"(acc[ai][bj][m][n]) : "v"(Bt##8[n]), "v"(At##8[m])); } \
        else { _Pragma("unroll") for (int k = 0; k < 2; ++k) \
            acc[ai][bj][m][n] = SWAP ? __builtin_amdgcn_mfma_f32_16x16x32_bf16(At[m][k], Bt[n][k], acc[ai][bj][m][n], 0, 0, 0) : __builtin_amdgcn_mfma_f32_16x16x32_bf16(Bt[n][k], At[m][k], acc[ai][bj][m][n], 0, 0, 0); } } \
        __builtin_amdgcn_s_setprio(0); } while (0)
#define PG8_WAIT_V(n) asm volatile("s_waitcnt vmcnt(" #n ")" ::: "memory")
    constexpr int RELAX = 8 + Epi::NSTORES;
#define PG8_WAIT_V8R(relax) do { if (relax) asm volatile("s_waitcnt vmcnt(%0)" :: "n"(RELAX) : "memory"); else asm volatile("s_waitcnt vmcnt(8)" ::: "memory"); } while (0)
#define PG8_WAIT_L(n) asm volatile("s_waitcnt lgkmcnt(" #n ")" ::: "memory")
#define PG8_BAR __builtin_amdgcn_s_barrier()
#define PG8_SCHED __builtin_amdgcn_sched_barrier(0)
    Unit cur, nxt; int ui = 0;
    if (!S.next(0, cur)) return;
    f32x4 acc[2][2][4][2];
    if constexpr (epi_has_prefetch<Epi>::value) {
        E.prefetch(cur, lane, wid);
        Unit u1; if (S.next(1, u1)) E.prefetch(u1, lane, wid); }
    if constexpr (epi_has_fold<Epi>::value) E.init_acc(acc, cur, wc, fq, false);
    else {
#pragma unroll
    for (int a = 0; a < 2; ++a)
#pragma unroll
        for (int b = 0; b < 2; ++b)
#pragma unroll
            for (int m = 0; m < 4; ++m)
#pragma unroll
                for (int n = 0; n < 2; ++n) acc[a][b][m][n] = (f32x4){0.f, 0.f, 0.f, 0.f};
    }
    bf16x8 At[4][2], B0[2][2], B1[2][2]; i32x8 At8[4], B08[2], B18[2];
#pragma unroll
    for (int h = 0; h < 2; ++h)
#pragma unroll
        for (int i = 0; i < 2; ++i) { const int row = GATHER ? g.gather[cur.arow0 + h * HALF + sR[i]] : (h * HALF + sR[i]); cvA[h][i] = (unsigned)row * lda2 + (unsigned)sC[i] * 2u; nidx[h][i] = 0; }
    const char* cA = (const char*)g.A + (GATHER ? (size_t)0 : (size_t)cur.arow0 * lda2); const char* cB = (const char*)g.Bt + (size_t)cur.brow0 * rowB;
    int rc = PG8_ROT(cur), rn = rc;
    PG8_STAGE(PG8_SB(0, 0), cB + PG8_KO(0, rc), voffB); PG8_STAGE(PG8_SB(0, 1), cB + hstepB + PG8_KO(0, rc), voffB); PG8_STAGE(PG8_SA(0, 0), cA + PG8_KO(0, rc), cvA[0]); PG8_STAGE(PG8_SA(0, 1), cA + PG8_KO(0, rc), cvA[1]);
    if (wr == 1) PG8_BAR;
    PG8_WAIT_V(2); PG8_BAR;
    PG8_STAGE(PG8_SB(1, 0), cB + PG8_KO(1, rc), voffB); PG8_STAGE(PG8_SA(1, 0), cA + PG8_KO(1, rc), cvA[0]); PG8_STAGE(PG8_SB(1, 1), cB + hstepB + PG8_KO(1, rc), voffB);
    PG8_WAIT_V(6); PG8_BAR;
    const char* pre_a = cA; unsigned pre_v[2] = {0u, 0u};
    for (;;) {
        const bool has_next = S.next(ui + 1, nxt);
        const char* nA = has_next ? (const char*)g.A + (GATHER ? (size_t)0 : (size_t)nxt.arow0 * lda2) : cA; const char* nB = has_next ? (const char*)g.Bt + (size_t)nxt.brow0 * rowB : cB; rn = has_next ? PG8_ROT(nxt) : rc;
        if (GATHER && has_next) {
#pragma unroll
            for (int h = 0; h < 2; ++h)
#pragma unroll
                for (int i = 0; i < 2; ++i) { const int* ip = g.gather + nxt.arow0 + h * HALF + sR[i]; asm volatile("global_load_dword %0, %1, off" : "=v"(nidx[h][i]) : "v"(ip) : "memory"); }
        }
#pragma unroll 1
        for (int t = 0; t < nt; t += 2) {
            const bool last = (t == nt - 2);
            const char* a1 = cA + PG8_KO(t + 1, rc);
            const size_t k2 = last ? PG8_KO(0, rn) : PG8_KO(t + 2, rc), k3 = last ? PG8_KO(1, rn) : PG8_KO(t + 3, rc);
            const char* a2 = (last ? nA : cA) + k2; const char* b2 = (last ? nB : cB) + k2;
            const char* a3 = (last ? nA : cA) + k3; const char* b3 = (last ? nB : cB) + k3;
            unsigned sv0[2], sv1[2];
#pragma unroll
            for (int i = 0; i < 2; ++i) { sv0[i] = cvA[0][i]; sv1[i] = cvA[1][i]; }
            if (GATHER && last && has_next) {
#pragma unroll
                for (int i = 0; i < 2; ++i) { asm volatile("" : "+v"(nidx[0][i]), "+v"(nidx[1][i])); sv0[i] = (unsigned)nidx[0][i] * lda2 + (unsigned)sC[i] * 2u; sv1[i] = (unsigned)nidx[1][i] * lda2 + (unsigned)sC[i] * 2u; }
            }
            const bool first = (t == 0) && (ui > 0);
            const bool relax = first && (Epi::NSTORES > 0);
            if (last) { pre_a = a3; pre_v[0] = sv1[0]; pre_v[1] = sv1[1]; }
            PG8_LDB(B0, 0, 0); PG8_LDB(B1, 0, 1); PG8_SCHED; PG8_LDA(At, 0, 0); if (!first) PG8_STAGE(PG8_SA(1, 1), a1, cvA[1]);
            PG8_WAIT_V8R(relax); PG8_WAIT_L(0); PG8_BAR; PG8_MMA(0, 0, At, B0); PG8_MMA(0, 1, At, B1); PG8_BAR; PG8_SCHED;
            PG8_LDA(At, 0, 1); PG8_STAGE(PG8_SB(0, 0), b2, voffB); PG8_STAGE(PG8_SB(0, 1), b2 + hstepB, voffB); PG8_STAGE(PG8_SA(0, 0), a2, sv0);
            PG8_WAIT_V8R(relax); PG8_WAIT_L(0); PG8_BAR; PG8_MMA(1, 0, At, B0); PG8_MMA(1, 1, At, B1); PG8_BAR; PG8_SCHED;
            PG8_LDB(B0, 1, 0); PG8_LDB(B1, 1, 1); PG8_SCHED; PG8_LDA(At, 1, 0); PG8_STAGE(PG8_SA(0, 1), a2, sv1);
            PG8_WAIT_V8R(relax); PG8_WAIT_L(0); PG8_BAR; PG8_MMA(0, 0, At, B0); PG8_MMA(0, 1, At, B1); PG8_BAR; PG8_SCHED;
            PG8_LDA(At, 1, 1); PG8_STAGE(PG8_SB(1, 0), b3, voffB); PG8_STAGE(PG8_SB(1, 1), b3 + hstepB, voffB); PG8_STAGE(PG8_SA(1, 0), a3, sv0);
            PG8_WAIT_V(8); PG8_WAIT_L(0); PG8_BAR; PG8_MMA(1, 0, At, B0); PG8_MMA(1, 1, At, B1); PG8_BAR; PG8_SCHED;
        }
        if (has_next) PG8_STAGE(PG8_SA(1, 1), pre_a, pre_v);
        asm volatile("" ::: "memory");
        if constexpr (epi_has_prefetch<Epi>::value) { Unit u2; if (S.next(ui + 2, u2)) E.prefetch(u2, lane, wid); asm volatile("" ::: "memory"); }
        if constexpr (ALIGN_EPI) { if (wr == 0) PG8_BAR; }
        if constexpr (FP8) {
#define PG8_ACC8(a_, b_) "+v"(acc[a_][b_][0][0]), "+v"(acc[a_][b_][0][1]), "+v"(acc[a_][b_][1][0]), "+v"(acc[a_][b_][1][1]), "+v"(acc[a_][b_][2][0]), "+v"(acc[a_][b_][2][1]), "+v"(acc[a_][b_][3][0]), "+v"(acc[a_][b_][3][1])
            asm volatile("s_nop 15\n\ts_nop 15\n\ts_nop 15" : PG8_ACC8(0, 0) :: "memory");
            asm volatile("" : PG8_ACC8(0, 1)); asm volatile("" : PG8_ACC8(1, 0)); asm volatile("" : PG8_ACC8(1, 1));
#undef PG8_ACC8
        }
        E(acc, cur, wr, wc, fr, fq);
        if (!has_next) break;
        if constexpr (epi_has_fold<Epi>::value) E.init_acc(acc, nxt, wc, fq, true);
        else {
#pragma unroll
        for (int a = 0; a < 2; ++a)
#pragma unroll
            for (int b = 0; b < 2; ++b)
#pragma unroll
                for (int m = 0; m < 4; ++m)
#pragma unroll
                    for (int n = 0; n < 2; ++n) acc[a][b][m][n] = (f32x4){0.f, 0.f, 0.f, 0.f};
        }
        cur = nxt; cA = nA; cB = nB; rc = rn; ++ui;
        if (GATHER) {
#pragma unroll
            for (int h = 0; h < 2; ++h)
#pragma unroll
                for (int i = 0; i < 2; ++i) cvA[h][i] = (unsigned)nidx[h][i] * lda2 + (unsigned)sC[i] * 2u;
        }
        if constexpr (ALIGN_EPI) { if (wr == 1) PG8_BAR; }
    }
    PG8_WAIT_V(0);
    if constexpr (!ALIGN_EPI) { if (wr == 0) PG8_BAR; }
    PG8_BAR;
#undef PG8_SA
#undef PG8_ROT
#undef PG8_KO
#undef PG8_SB
#undef PG8_STAGE
#undef PG8_LDA
#undef PG8_LDB
#undef PG8_MMA
#undef PG8_WAIT_V
#undef PG8_WAIT_V8R
#undef PG8_WAIT_L
#undef PG8_BAR
#undef PG8_SCHED
}
}
#define GEMM_PHASE(l, g, S, E) pg8::gemm_phase_mfma<decltype(E), decltype(S), false, true>(l, g, S, E)
#define GEMM_PHASE_G(l, g, S, E) pg8::gemm_phase_mfma<decltype(E), decltype(S), true, true>(l, g, S, E)
#define GEMM_PHASE_F8(l, g, S, E) pg8::gemm_phase_mfma<decltype(E), decltype(S), false, true, false, true>(l, g, S, E)
#define GEMM_PHASE_F8G(l, g, S, E) pg8::gemm_phase_mfma<decltype(E), decltype(S), true, true, false, true>(l, g, S, E)
#define GEMM_PHASE_SWAP(l, g, S, E) pg8::gemm_phase_mfma<decltype(E), decltype(S), false, true, true>(l, g, S, E)

struct TrJob { const float* W; int ldw, K; bf16_t* WT; const float* kg0; const float* kg1; int ksplit; float scale;
               int nb; size_t wbs, wtbs; int nseg, segn, src0, srcstride, dst0, dststride; int q8; };
__device__ __forceinline__ void tr_item(const TrJob& J, int item, LAS float* scr, int lane) {
    const int kblocks = J.K / 64, nblk = (J.segn + 31) / 32;
    int r = item; const int kb = r % kblocks; r /= kblocks; const int nbk = r % nblk; r /= nblk; const int seg = r % J.nseg; const int b = r / J.nseg;
    const int k0 = kb * 64, nsrc = J.src0 + seg * J.srcstride + nbk * 32, ndst = J.dst0 + seg * J.dststride + nbk * 32, nvalid = J.segn - nbk * 32;
    const float* W = J.W + (size_t)b * J.wbs; bf16_t* WT = J.WT + (size_t)b * J.wtbs;
#pragma unroll 8
    for (int i = 0; i < 32; ++i) { const int kk = 2 * i + (lane >> 5), n = lane & 31, k = k0 + kk;
        float v = 0.f;
        if (n < nvalid) { v = W[(size_t)k * J.ldw + nsrc + n] * J.scale; if (J.kg0) v *= (k < J.ksplit) ? J.kg0[k] : J.kg1[k - J.ksplit]; }
        scr[kk * 33 + n] = v; }
    asm volatile("s_waitcnt lgkmcnt(0)" ::: "memory");
    const int c = lane & 7;
#pragma unroll
    for (int j = 0; j < 4; ++j) { const int n = (lane >> 3) + 8 * j; const LAS float* s = scr + (8 * c) * 33 + n;
        if (J.q8) { u32x2 o8; o8.x = pk4_fp8(clamp_fp8(s[0 * 33] * 32.f), clamp_fp8(s[1 * 33] * 32.f), clamp_fp8(s[2 * 33] * 32.f), clamp_fp8(s[3 * 33] * 32.f));
            o8.y = pk4_fp8(clamp_fp8(s[4 * 33] * 32.f), clamp_fp8(s[5 * 33] * 32.f), clamp_fp8(s[6 * 33] * 32.f), clamp_fp8(s[7 * 33] * 32.f));
            if (n < nvalid) *(u32x2*)((unsigned char*)WT + (size_t)(ndst + n) * J.K + k0 + 8 * c) = o8; }
        else { u32x4 o; o.x = pk2(s[0 * 33], s[1 * 33]); o.y = pk2(s[2 * 33], s[3 * 33]); o.z = pk2(s[4 * 33], s[5 * 33]); o.w = pk2(s[6 * 33], s[7 * 33]);
            if (n < nvalid) *(u32x4*)(WT + (size_t)(ndst + n) * J.K + k0 + 8 * c) = o; } }
    asm volatile("s_waitcnt lgkmcnt(0)" ::: "memory");
}
__device__ __forceinline__ void tr_job(const Frame& F, const TrJob& J, int& off) {
    LAS float* scr = (LAS float*)(F.lds + F.wave * 16384);
    const int nitems = J.nb * J.nseg * ((J.segn + 31) / 32) * (J.K / 64), ngw = F.G * NWAVES;
    int it = (F.bid * NWAVES + F.wave - off % ngw); if (it < 0) it += ngw;
    for (; it < nitems; it += ngw) tr_item(J, it, scr, F.lane);
    off += nitems;
}

__device__ __forceinline__ void ph0_prep(const Frame& F, const Args& args) {
    unsigned char* ws = args.ws;
    const bool split = F.G >= 192; const bool do_mod = !split || F.bid < 96, do_aux = !split || F.bid >= 96;
    Frame FA = F; if (split) { FA.bid = F.bid - 96; FA.G = F.G - 96; }
    if (do_mod) {
        LAS float* cact = (LAS float*)F.lds;
        LAS float* red = cact + 16 * 1024;
        const float* c = IN_F(1); const float* w_ada = IN_F(3); const float* b_ada = IN_F(4); float* mod = (float*)(ws + WS_MOD);
        for (int i = F.tid; i < 16 * 1024; i += NTHR) { const float v = c[i]; cact[i] = v / (1.f + expf(-v)); }
        __syncthreads();
        for (int u = F.bid; u < 96; u += F.G) {
            const int j = u * 64 + F.lane; float acc[16];
#pragma unroll
            for (int b = 0; b < 16; ++b) acc[b] = 0.f;
            for (int k0 = F.wave * 128; k0 < F.wave * 128 + 128; k0 += 32) { float w[32];
#pragma unroll
                for (int kk = 0; kk < 32; ++kk) w[kk] = w_ada[(size_t)(k0 + kk) * 6144 + j];
#pragma unroll
                for (int kk = 0; kk < 32; ++kk)
#pragma unroll
                    for (int b = 0; b < 16; ++b) acc[b] += cact[b * 1024 + k0 + kk] * w[kk]; }
#pragma unroll
            for (int b = 0; b < 16; ++b) red[(F.wave * 16 + b) * 64 + F.lane] = acc[b];
            __syncthreads();
            for (int o = F.tid; o < 1024; o += NTHR) { const int b = o >> 6, l = o & 63; float s = 0.f;
#pragma unroll
                for (int w = 0; w < 8; ++w) s += red[(w * 16 + b) * 64 + l];
                mod[b * 6144 + u * 64 + l] = s + b_ada[u * 64 + l]; }
            __syncthreads();
        }
        __syncthreads();
    }
    if (!do_aux) return;
    {
        const int* pos = IN_I(2); float* cs = (float*)(ws + WS_COS); float* sn = (float*)(ws + WS_SIN);
        const double invrev = pow(10000.0, -(double)(2 * (F.tid & 15)) / 32.0) * 0.15915494309189535;
        for (int idx = FA.bid * NTHR + F.tid; idx < NTOK * 16; idx += FA.G * NTHR) { const int tok = idx >> 4;
            const double rev = (double)pos[tok] * invrev; const float frac = (float)(rev - __builtin_rint(rev));
            cs[idx] = __builtin_amdgcn_cosf(frac); sn[idx] = __builtin_amdgcn_sinf(frac); }
    }
    const float qscale = 0.10206207261596575f * 1.4426950408889634f;
    TrJob J; int off = 0;
    J = TrJob{IN_F(6), IN_COLS, 1024, (bf16_t*)(ws + WS_WIN_T), nullptr, nullptr, 1024, 1.f, 1, 0, 0, 1, 1536, 0, 0, 0, 0, 1}; tr_job(FA, J, off);
    J = TrJob{IN_F(6), IN_COLS, 1024, (bf16_t*)(ws + WS_WIN_T), nullptr, nullptr, 1024, 1.f, 1, 0, 0, 1, 8, 1536, 0, PC_DT, 0, 1}; tr_job(FA, J, off);
    J = TrJob{IN_F(6), IN_COLS, 1024, (bf16_t*)(ws + WS_WIN_T), nullptr, nullptr, 1024, 1.f, 1, 0, 0, 1, 384, 1544, 0, PC_QA, 0, 1}; tr_job(FA, J, off);
    J = TrJob{IN_F(6), IN_COLS, 1024, (bf16_t*)(ws + WS_WIN_T), nullptr, nullptr, 1024, 1.f, 1, 0, 0, 1, 256, 1928, 0, PC_KVA, 0, 1}; tr_job(FA, J, off);
    J = TrJob{IN_F(6), IN_COLS, 1024, (bf16_t*)(ws + WS_WIN_T), nullptr, nullptr, 1024, 1.f, 1, 0, 0, 1, 32, 2184, 0, PC_KR, 0, 1}; tr_job(FA, J, off);
    J = TrJob{IN_F(14), 768, 384, (bf16_t*)(ws + WS_WQ_T), IN_F(13), IN_F(13), 384, qscale, 1, 0, 0, 8, 64, 0, 96, 0, 64}; tr_job(FA, J, off);
    J = TrJob{IN_F(14), 768, 384, (bf16_t*)(ws + WS_WQ_T), IN_F(13), IN_F(13), 384, qscale, 1, 0, 0, 8, 32, 64, 96, 512, 32}; tr_job(FA, J, off);
    J = TrJob{IN_F(16), 1024, 256, (bf16_t*)(ws + WS_WKV_T), IN_F(15), IN_F(15), 256, 1.f, 1, 0, 0, 8, 64, 0, 128, 0, 64}; tr_job(FA, J, off);
    J = TrJob{IN_F(16), 1024, 256, (bf16_t*)(ws + WS_WKV_T), IN_F(15), IN_F(15), 256, 1.f, 1, 0, 0, 8, 64, 64, 128, 512, 64}; tr_job(FA, J, off);
    J = TrJob{IN_F(18), 1024, 1024, (bf16_t*)(ws + WS_WOUT_T), IN_F(12), IN_F(17), 512, 1.f, 1, 0, 0, 1, 1024, 0, 0, 0, 0, 1}; tr_job(FA, J, off);
    J = TrJob{IN_F(21), 32, 1024, (bf16_t*)(ws + WS_WR_T), nullptr, nullptr, 1024, 1.f, 1, 0, 0, 1, 32, 0, 0, 0, 0}; tr_job(FA, J, off);
}
__device__ __forceinline__ void tr8_item(const float* W, int ldw, int K, unsigned char* WT, int nsrc, int ndst, int k0, LAS unsigned* scr, int lane) {
    const int kq = lane >> 4, n4 = lane & 15;
    f32x4 v[4][4];
#pragma unroll
    for (int i = 0; i < 4; ++i)
#pragma unroll
        for (int r = 0; r < 4; ++r) v[i][r] = __builtin_nontemporal_load((const f32x4*)(W + (size_t)(k0 + 16 * i + 4 * kq + r) * ldw + nsrc + 4 * n4));
#pragma unroll
    for (int i = 0; i < 4; ++i)
#pragma unroll
        for (int e = 0; e < 4; ++e) scr[(4 * i + kq) * 65 + 4 * n4 + e] = pk4_fp8(clamp_fp8(v[i][0][e] * W8_SCALE), clamp_fp8(v[i][1][e] * W8_SCALE), clamp_fp8(v[i][2][e] * W8_SCALE), clamp_fp8(v[i][3][e] * W8_SCALE));
    asm volatile("s_waitcnt lgkmcnt(0)" ::: "memory");
    const int c = lane & 3;
#pragma unroll
    for (int j = 0; j < 4; ++j) { const int n = (lane >> 2) + 16 * j; u32x4 o;
        o.x = scr[(4 * c + 0) * 65 + n]; o.y = scr[(4 * c + 1) * 65 + n]; o.z = scr[(4 * c + 2) * 65 + n]; o.w = scr[(4 * c + 3) * 65 + n];
        *(u32x4*)(WT + (size_t)(ndst + n) * K + k0 + 16 * c) = o; }
    asm volatile("s_waitcnt lgkmcnt(0)" ::: "memory");
}
__device__ __forceinline__ void ph_moe_weights(const Frame& F, const Args& args) {
    unsigned char* ws = args.ws; LAS unsigned* scr = (LAS unsigned*)(F.lds + F.wave * 8192);
    const int gw = F.bid * NWAVES + F.wave, NGW = F.G * NWAVES;
    for (int it = gw; it < 32 * 16 * 16; it += NGW) { const int kb = it & 15, nb = (it >> 4) & 15, e = it >> 8;
        tr8_item(IN_F(25) + (size_t)e * 1024 * 1024, 1024, 1024, ws + WS_WDN_T + (size_t)e * 1024 * 1024, nb * 64, nb * 64, kb * 64, scr, F.lane); }
}

__device__ __forceinline__ void ph1_h1(const Frame& F, const Args& args) {
    const float* x = IN_F(0); const float* gain = IN_F(5); const float* mod = (const float*)(args.ws + WS_MOD); bf16_t* h1 = (bf16_t*)(args.ws + WS_H1);
    for (int m0 = (F.bid * NWAVES + F.wave) * 4; m0 < NTOK; m0 += F.G * NWAVES * 4) {
        const int b = m0 >> 12; f32x4 v[4][4]; float ss[4];
#pragma unroll
        for (int r = 0; r < 4; ++r)
#pragma unroll
            for (int j = 0; j < 4; ++j) v[r][j] = __builtin_nontemporal_load((const f32x4*)(x + (size_t)(m0 + r) * DM + 4 * F.lane + 256 * j));
#pragma unroll
        for (int r = 0; r < 4; ++r) { float t = 0.f;
#pragma unroll
            for (int j = 0; j < 4; ++j) t += v[r][j][0] * v[r][j][0] + v[r][j][1] * v[r][j][1] + v[r][j][2] * v[r][j][2] + v[r][j][3] * v[r][j][3];
            ss[r] = t; }
#pragma unroll
        for (int o = 1; o < 64; o <<= 1) {
#pragma unroll
            for (int r = 0; r < 4; ++r) ss[r] += __shfl_xor(ss[r], o); }
#pragma unroll
        for (int j = 0; j < 4; ++j) { const int col = 4 * F.lane + 256 * j; const f32x4 g = *(const f32x4*)(gain + col), sh = *(const f32x4*)(mod + b * 6144 + col), sc = *(const f32x4*)(mod + b * 6144 + 1024 + col) + 1.f;
#pragma unroll
            for (int r = 0; r < 4; ++r) { const float rstd = 1.f / sqrtf(ss[r] * (1.f / DM) + NORM_EPS); { const f32x4 hv = v[r][j] * rstd * g * sc + sh; *(unsigned*)((unsigned char*)h1 + (size_t)(m0 + r) * DM + col) = pk4_fp8(clamp_fp8(hv[0]), clamp_fp8(hv[1]), clamp_fp8(hv[2]), clamp_fp8(hv[3])); } } }
    }
}

__device__ __forceinline__ f32x4 bf_lo4(u32x4 v) { return (f32x4){__uint_as_float(v[0] << 16), __uint_as_float(v[0] & 0xffff0000u), __uint_as_float(v[1] << 16), __uint_as_float(v[1] & 0xffff0000u)}; }
__device__ __forceinline__ f32x4 bf_hi4(u32x4 v) { return (f32x4){__uint_as_float(v[2] << 16), __uint_as_float(v[2] & 0xffff0000u), __uint_as_float(v[3] << 16), __uint_as_float(v[3] & 0xffff0000u)}; }
__device__ __forceinline__ void ph3_tokprep(const Frame& F, const Args& args) {
    unsigned char* ws = args.ws; const bf16_t* proj = (const bf16_t*)(ws + WS_PROJ); bf16_t* xbc = (bf16_t*)(ws + WS_XBC);
    const float* conv_w = IN_F(7); const float* conv_b = IN_F(8); const float* dt_bias = IN_F(9);
    float* dtb = (float*)(ws + WS_DT); float* rq = (float*)(ws + WS_RSTDQ); float* rkv = (float*)(ws + WS_RSTDKV);
    const float* cs = (const float*)(ws + WS_COS); const float* sn = (const float*)(ws + WS_SIN); bf16_t* kr = (bf16_t*)(ws + WS_KR);
    const int lane = F.lane;
    for (int m0 = (F.bid * NWAVES + F.wave) * 8; m0 < NTOK; m0 += F.G * NWAVES * 8) {
        const int s0 = m0 & (SEQ - 1);
        {   const int t = lane >> 3, part = lane & 7; const bf16_t* pr = proj + (size_t)(m0 + t) * PROJ_LD;
            { const float xv = bf2f(pr[PC_DT + part]) + dt_bias[part]; dtb[(size_t)(m0 + t) * 8 + part] = xv > 20.f ? xv : log1pf(expf(xv)); }
            float sq = 0.f, skv = 0.f;
#pragma unroll
            for (int i = 0; i < 6; ++i) { const u32x4 v = *(const u32x4*)(pr + PC_QA + part * 48 + 8 * i); const f32x4 a = bf_lo4(v), b2 = bf_hi4(v); sq += a[0] * a[0] + a[1] * a[1] + a[2] * a[2] + a[3] * a[3] + b2[0] * b2[0] + b2[1] * b2[1] + b2[2] * b2[2] + b2[3] * b2[3]; }
#pragma unroll
            for (int i = 0; i < 4; ++i) { const u32x4 v = *(const u32x4*)(pr + PC_KVA + part * 32 + 8 * i); const f32x4 a = bf_lo4(v), b2 = bf_hi4(v); skv += a[0] * a[0] + a[1] * a[1] + a[2] * a[2] + a[3] * a[3] + b2[0] * b2[0] + b2[1] * b2[1] + b2[2] * b2[2] + b2[3] * b2[3]; }
#pragma unroll
            for (int o = 1; o < 8; o <<= 1) { sq += __shfl_xor(sq, o); skv += __shfl_xor(skv, o); }
            if (part == 0) { rq[m0 + t] = 1.f / sqrtf(sq * (1.f / Q_LORA) + NORM_EPS); rkv[m0 + t] = 1.f / sqrtf(skv * (1.f / KV_LORA) + NORM_EPS); }
            const unsigned x1p = *(const unsigned*)(pr + PC_KR + 2 * part), x2p = *(const unsigned*)(pr + PC_KR + 16 + 2 * part);
            const f32x2 c2 = *(const f32x2*)(cs + (size_t)(m0 + t) * 16 + 2 * part), s2 = *(const f32x2*)(sn + (size_t)(m0 + t) * 16 + 2 * part);
            const float x1a = __uint_as_float(x1p << 16), x1b = __uint_as_float(x1p & 0xffff0000u), x2a = __uint_as_float(x2p << 16), x2b = __uint_as_float(x2p & 0xffff0000u);
            *(unsigned*)(kr + (size_t)(m0 + t) * 32 + 2 * part) = pk2(x1a * c2[0] - x2a * s2[0], x1b * c2[1] - x2b * s2[1]);
            *(unsigned*)(kr + (size_t)(m0 + t) * 32 + 16 + 2 * part) = pk2(x2a * c2[0] + x1a * s2[0], x2b * c2[1] + x1b * s2[1]);
        }
#pragma unroll
        for (int j = 0; j < 2; ++j) { const int ch = 8 * lane + 512 * j;
            u32x4 v[11];
#pragma unroll
            for (int r = 0; r < 11; ++r) { if (r >= 3 || s0 > 0) v[r] = *(const u32x4*)(proj + (size_t)(m0 + r - 3) * PROJ_LD + PC_XBC + ch); else v[r] = (u32x4){0u, 0u, 0u, 0u}; }
            f32x4 wl[4], wh[4];
#pragma unroll
            for (int jj = 0; jj < 4; ++jj) { wl[jj] = *(const f32x4*)(conv_w + jj * XBC_DIM + ch); wh[jj] = *(const f32x4*)(conv_w + jj * XBC_DIM + ch + 4); }
            const f32x4 bl = *(const f32x4*)(conv_b + ch), bh = *(const f32x4*)(conv_b + ch + 4);
#pragma unroll
            for (int t = 0; t < 8; ++t) { f32x4 al = bl, ah = bh;
#pragma unroll
                for (int jj = 0; jj < 4; ++jj) { al += bf_lo4(v[t + jj]) * wl[jj]; ah += bf_hi4(v[t + jj]) * wh[jj]; }
#pragma unroll
                for (int i = 0; i < 4; ++i) { al[i] = al[i] * __builtin_amdgcn_rcpf(1.f + __expf(-al[i])); ah[i] = ah[i] * __builtin_amdgcn_rcpf(1.f + __expf(-ah[i])); }
                u32x4 o; o.x = pk2(al[0], al[1]); o.y = pk2(al[2], al[3]); o.z = pk2(ah[0], ah[1]); o.w = pk2(ah[2], ah[3]);
                *(u32x4*)(xbc + (size_t)(m0 + t) * XBC_DIM + ch) = o; } }
    }
}

constexpr size_t WS_YMIX8 = WS_Q;
constexpr size_t WS_STATES = WS_H1;
constexpr size_t WS_CDEC = 12 * MiB + 768 * 1024;
__device__ __forceinline__ int ssd_pos(int l) { return (l & 32) | (((l >> 2) & 3) << 3) | (((l >> 4) & 1) << 2) | (l & 3); }
__device__ __forceinline__ int img_off(int r, int c, int nst) { const int ob = (r & 15) * 64 + (c & 31) * 2; return ((r >> 4) * nst + (c >> 5)) * 1024 + (ob ^ (((ob >> 9) & 1) << 5)); }
__device__ __forceinline__ float wave_incl_scan(float v, int lane) {
#pragma unroll
    for (int off = 1; off < 64; off <<= 1) { const float t = __shfl_up(v, off); if (lane >= off) v += t; }
    return v;
}
template <class WF>
__device__ __forceinline__ void ssd_build_xsT(LAS unsigned char* img, const bf16_t* xbc, int m0, int h, int lane, const WF& wl) {
    const int rp = lane >> 3, cg = lane & 7;
    u32x4 v0[4], v1[4];
#pragma unroll
    for (int i = 0; i < 4; ++i) { const bf16_t* r0 = xbc + (size_t)(m0 + 2 * (8 * i + rp)) * XBC_DIM + h * 64 + 8 * cg; v0[i] = *(const u32x4*)r0; v1[i] = *(const u32x4*)(r0 + XBC_DIM); }
#pragma unroll
    for (int i = 0; i < 4; ++i) { const int l0 = 2 * (8 * i + rp), pos0 = ssd_pos(l0); const float w0 = wl(l0), w1 = wl(l0 + 1);
#pragma unroll
        for (int e = 0; e < 4; ++e) { const int p = 8 * cg + 2 * e;
            const float a0 = __uint_as_float(v0[i][e] << 16) * w0, a1 = __uint_as_float(v0[i][e] & 0xffff0000u) * w0, b0 = __uint_as_float(v1[i][e] << 16) * w1, b1 = __uint_as_float(v1[i][e] & 0xffff0000u) * w1;
            *(LAS unsigned*)(img + img_off(p, pos0, 2)) = pk2(a0, b0); *(LAS unsigned*)(img + img_off(p + 1, pos0, 2)) = pk2(a1, b1); } }
}
__device__ __forceinline__ int inv_perm32(int n) { return 16 * ((n >> 2) & 1) + 4 * (n >> 3) + (n & 3); }
__device__ __forceinline__ void ssd_phase_a(const Frame& F, const Args& args) {
    unsigned char* ws = args.ws; const bf16_t* xbc = (const bf16_t*)(ws + WS_XBC); const float* dtb = (const float*)(ws + WS_DT); bf16_t* states = (bf16_t*)(ws + WS_STATES); float* cdec = (float*)(ws + WS_CDEC);
    const int h = F.wave, gg = h >> 2, wq = h & 3, lane = F.lane, fr = lane & 15, fq = lane >> 4;
    const float a = -expf(IN_F(10)[h]);
    LAS unsigned char* xsT = F.lds + h * 8192; LAS unsigned char* BT = F.lds + 65536 + gg * 16384;
    const int foff = (fr * 64 + fq * 16) ^ ((((fr * 64 + fq * 16) >> 9) & 1) << 5);
    for (int u = F.bid; u < BATCH * NCHUNK; u += F.G) {
        const int b = u >> 6, c = u & 63, m0 = b * SEQ + c * 64;
        u32x4 bv0[2], bv1[2];
#pragma unroll
        for (int i = 0; i < 2; ++i) { const bf16_t* r0 = xbc + (size_t)(m0 + 2 * (16 * i + (lane >> 2))) * XBC_DIM + 512 + gg * 128 + 32 * wq + 8 * (lane & 3); bv0[i] = *(const u32x4*)r0; bv1[i] = *(const u32x4*)(r0 + XBC_DIM); }
        const float dtv = dtb[(size_t)(m0 + lane) * 8 + h]; const float cs = wave_incl_scan(dtv * a, lane); const float cs_end = __shfl(cs, 63);
        const float wst = dtv * __expf(cs_end - cs);
        if (lane == 0) cdec[u * 8 + h] = __expf(cs_end);
        ssd_build_xsT(xsT, xbc, m0, h, lane, [&](int l) { return __shfl(wst, l); });
#pragma unroll
        for (int i = 0; i < 2; ++i) { const int l0 = 2 * (16 * i + (lane >> 2)), pos0 = ssd_pos(l0), n0 = 32 * wq + 8 * (lane & 3);
#pragma unroll
            for (int e = 0; e < 4; ++e) { const int n = n0 + 2 * e, r0 = (n & ~31) + inv_perm32(n & 31), r1 = ((n + 1) & ~31) + inv_perm32((n + 1) & 31);
                *(LAS unsigned*)(BT + img_off(r0, pos0, 2)) = (bv0[i][e] & 0xffffu) | (bv1[i][e] << 16); *(LAS unsigned*)(BT + img_off(r1, pos0, 2)) = (bv0[i][e] >> 16) | (bv1[i][e] & 0xffff0000u); } }
        __syncthreads();
        f32x4 acc[8][4];
#pragma unroll
        for (int nb = 0; nb < 8; ++nb)
#pragma unroll
            for (int pb = 0; pb < 4; ++pb) acc[nb][pb] = (f32x4){0.f, 0.f, 0.f, 0.f};
#pragma unroll
        for (int s2 = 0; s2 < 2; ++s2) { bf16x8 xf[4];
#pragma unroll
            for (int pb = 0; pb < 4; ++pb) xf[pb] = *(const LAS bf16x8*)(xsT + (pb * 2 + s2) * 1024 + foff);
#pragma unroll
            for (int nb = 0; nb < 8; ++nb) { const bf16x8 af = *(const LAS bf16x8*)(BT + (nb * 2 + s2) * 1024 + foff);
#pragma unroll
                for (int pb = 0; pb < 4; ++pb) acc[nb][pb] = __builtin_amdgcn_mfma_f32_16x16x32_bf16(af, xf[pb], acc[nb][pb], 0, 0, 0); } }
        bf16_t* sp = states + ((size_t)u * 8 + h) * 8192;
#pragma unroll
        for (int pb = 0; pb < 4; ++pb)
#pragma unroll
            for (int k2 = 0; k2 < 4; ++k2) st_bf16x8(sp + (16 * pb + fr) * 128 + 32 * k2 + 8 * fq, acc[2 * k2][pb], acc[2 * k2 + 1][pb]);
        __syncthreads();
    }
}
__device__ __forceinline__ void ssd_phase_b(const Frame& F, const Args& args) {
    unsigned char* ws = args.ws; bf16_t* states = (bf16_t*)(ws + WS_STATES); const float* cdec = (const float*)(ws + WS_CDEC);
    for (int gid = gtid(F); gid < BATCH * 8 * 64 * 16; gid += F.G * NTHR) {
        const int n8 = gid & 15, p = (gid >> 4) & 63, h = (gid >> 10) & 7, b = gid >> 13;
        bf16_t* ptr = states + ((size_t)(b * 64) * 8 + h) * 8192 + p * 128 + n8 * 8;
        float run[8];
#pragma unroll
        for (int i = 0; i < 8; ++i) run[i] = 0.f;
        for (int c0 = 0; c0 < NCHUNK; c0 += 8) { u32x4 v[8]; float dec[8];
#pragma unroll
            for (int j = 0; j < 8; ++j) { v[j] = *(const u32x4*)(ptr + (size_t)(c0 + j) * 65536); dec[j] = cdec[(b * 64 + c0 + j) * 8 + h]; }
#pragma unroll
            for (int j = 0; j < 8; ++j) { u32x4 o; o.x = pk2(run[0], run[1]); o.y = pk2(run[2], run[3]); o.z = pk2(run[4], run[5]); o.w = pk2(run[6], run[7]);
                *(u32x4*)(ptr + (size_t)(c0 + j) * 65536) = o;
#pragma unroll
                for (int i = 0; i < 4; ++i) { run[2 * i] = run[2 * i] * dec[j] + __uint_as_float(v[j][i] << 16); run[2 * i + 1] = run[2 * i + 1] * dec[j] + __uint_as_float(v[j][i] & 0xffff0000u); } } }
    }
}
constexpr int SSDC_C = 65536, SSDC_B = 98304, SSDC_CS = 131072, SSDC_DT = 133120, SSDC_SSQ = 137216;
__device__ __forceinline__ void ssd_phase_c(const Frame& F, const Args& args) {
    unsigned char* ws = args.ws; const bf16_t* xbc = (const bf16_t*)(ws + WS_XBC); const bf16_t* proj = (const bf16_t*)(ws + WS_PROJ); const float* dtb = (const float*)(ws + WS_DT);
    const bf16_t* states = (const bf16_t*)(ws + WS_STATES); bf16_t* ymix = (bf16_t*)(ws + WS_YMIX); unsigned char* ymix8 = ws + WS_YMIX8;
    const int h = F.wave, gg = h >> 2, lane = F.lane, fr = lane & 15, fq = lane >> 4;
    const float a = -expf(IN_F(10)[h]), dsk = IN_F(11)[h];
    LAS unsigned char* xsT = F.lds + h * 8192; LAS float* csT = (LAS float*)(F.lds + SSDC_CS) + h * 64; LAS float* dtT = (LAS float*)(F.lds + SSDC_DT) + h * 64; LAS float* ssqT = (LAS float*)(F.lds + SSDC_SSQ);
    const LAS unsigned char* Cimg = F.lds + SSDC_C + gg * 16384; const LAS unsigned char* Bimg = F.lds + SSDC_B + gg * 16384;
    const int foff = (fr * 64 + fq * 16) ^ ((((fr * 64 + fq * 16) >> 9) & 1) << 5);
    const int sb_ = lane * 16, swz_ = sb_ ^ (((sb_ >> 9) & 1) << 5), rr = swz_ >> 6, cc = (swz_ & 63) >> 1;
    for (int q = 0; ; ++q) { const int pm_ = F.vcu + (q >> 2) * F.G; if (pm_ >= NTOK / 256) break; const int u = 4 * pm_ + (q & 3);
        const int b = u >> 6, c = u & 63, m0 = b * SEQ + c * 64;
#pragma unroll
        for (int k = 0; k < 8; ++k) { const int j = 8 * h + k; const int mat = j >> 5, g2 = (j >> 4) & 1, lb = (j >> 2) & 3, ns = j & 3;
            __builtin_amdgcn_global_load_lds((const unsigned*)(xbc + (size_t)(m0 + 16 * lb + rr) * XBC_DIM + (mat ? 512 : 768) + g2 * 128 + 32 * ns + cc), (LAS unsigned*)(F.lds + (mat ? SSDC_B : SSDC_C) + g2 * 16384 + (lb * 4 + ns) * 1024), 16, 0, 0); }
        const bf16_t* prev = states + ((size_t)u * 8 + h) * 8192;
        bf16x8 pfr[4][4];
#pragma unroll
        for (int pb = 0; pb < 4; ++pb)
#pragma unroll
            for (int ns = 0; ns < 4; ++ns) pfr[pb][ns] = *(const bf16x8*)(prev + (16 * pb + fr) * 128 + 32 * ns + 8 * fq);
        const float dtv = dtb[(size_t)(m0 + lane) * 8 + h]; const float cs = wave_incl_scan(dtv * a, lane);
        csT[lane] = cs; dtT[lane] = dtv;
        ssd_build_xsT(xsT, xbc, m0, h, lane, [](int) { return 1.f; });
        asm volatile("s_waitcnt vmcnt(0)" ::: "memory");
        __syncthreads();
        u32x2 yk[4][4];
#pragma unroll
        for (int lb = 0; lb < 4; ++lb) {
            const int l = 16 * lb + fr; const bf16_t* xrow = xbc + (size_t)(m0 + l) * XBC_DIM;
            u32x2 xs_r[4], z_r[4];
#pragma unroll
            for (int pb = 0; pb < 4; ++pb) { xs_r[pb] = *(const u32x2*)(xrow + h * 64 + 16 * pb + 4 * fq); z_r[pb] = *(const u32x2*)(proj + (size_t)(m0 + l) * PROJ_LD + PC_Z + h * 64 + 16 * pb + 4 * fq); }
            bf16x8 Cf[4];
#pragma unroll
            for (int ns = 0; ns < 4; ++ns) Cf[ns] = *(const LAS bf16x8*)(Cimg + (lb * 4 + ns) * 1024 + foff);
            f32x4 acc2[4];
#pragma unroll
            for (int pb = 0; pb < 4; ++pb) acc2[pb] = (f32x4){0.f, 0.f, 0.f, 0.f};
#pragma unroll
            for (int ns = 0; ns < 4; ++ns)
#pragma unroll
                for (int pb = 0; pb < 4; ++pb) acc2[pb] = __builtin_amdgcn_mfma_f32_16x16x32_bf16(pfr[pb][ns], Cf[ns], acc2[pb], 0, 0, 0);
            const float csl = csT[l]; const float ecl = __expf(csl);
            f32x4 M[4];
#pragma unroll
            for (int sb = 0; sb < 4; ++sb) M[sb] = (f32x4){0.f, 0.f, 0.f, 0.f};
#pragma unroll
            for (int ns = 0; ns < 4; ++ns)
#pragma unroll
                for (int sb = 0; sb < 4; ++sb) { if (sb <= lb) { const bf16x8 af = *(const LAS bf16x8*)(Bimg + (sb * 4 + ns) * 1024 + foff); M[sb] = __builtin_amdgcn_mfma_f32_16x16x32_bf16(af, Cf[ns], M[sb], 0, 0, 0); } }
#pragma unroll
            for (int sb = 0; sb < 4; ++sb) { if (sb <= lb) {
                    const f32x4 cs4 = *(const LAS f32x4*)(csT + 16 * sb + 4 * fq), dt4 = *(const LAS f32x4*)(dtT + 16 * sb + 4 * fq);
#pragma unroll
                    for (int i = 0; i < 4; ++i) { const int sidx = 16 * sb + 4 * fq + i; M[sb][i] = (sidx <= l) ? M[sb][i] * __expf(csl - cs4[i]) * dt4[i] : 0.f; } } }
            bf16x8 pf[2];
#pragma unroll
            for (int ks = 0; ks < 2; ++ks) { u32x4 w; w.x = pk2(M[2 * ks][0], M[2 * ks][1]); w.y = pk2(M[2 * ks][2], M[2 * ks][3]); w.z = pk2(M[2 * ks + 1][0], M[2 * ks + 1][1]); w.w = pk2(M[2 * ks + 1][2], M[2 * ks + 1][3]); pf[ks] = __builtin_bit_cast(bf16x8, w); }
            float sq = 0.f;
#pragma unroll
            for (int pb = 0; pb < 4; ++pb) { f32x4 yd = (f32x4){0.f, 0.f, 0.f, 0.f};
#pragma unroll
                for (int ks = 0; ks < 2; ++ks) { if (2 * ks <= lb) { const bf16x8 af = *(const LAS bf16x8*)(xsT + (pb * 2 + ks) * 1024 + foff); yd = __builtin_amdgcn_mfma_f32_16x16x32_bf16(af, pf[ks], yd, 0, 0, 0); } }
                const f32x4 xs4 = (f32x4){__uint_as_float(xs_r[pb].x << 16), __uint_as_float(xs_r[pb].x & 0xffff0000u), __uint_as_float(xs_r[pb].y << 16), __uint_as_float(xs_r[pb].y & 0xffff0000u)};
                const f32x4 z4 = (f32x4){__uint_as_float(z_r[pb].x << 16), __uint_as_float(z_r[pb].x & 0xffff0000u), __uint_as_float(z_r[pb].y << 16), __uint_as_float(z_r[pb].y & 0xffff0000u)};
                f32x4 yy = yd + acc2[pb] * ecl + xs4 * dsk;
#pragma unroll
                for (int i = 0; i < 4; ++i) { yy[i] *= z4[i] * __builtin_amdgcn_rcpf(1.f + __expf(-z4[i])); sq += yy[i] * yy[i]; }
                yk[lb][pb].x = pk2(yy[0], yy[1]); yk[lb][pb].y = pk2(yy[2], yy[3]); }
            sq += __shfl_xor(sq, 16); sq += __shfl_xor(sq, 32);
            if (fq == 0) ssqT[h * 64 + l] = sq;
        }
        __syncthreads();
#pragma unroll
        for (int lb = 0; lb < 4; ++lb) { const int l = 16 * lb + fr; const float tot = ssqT[(gg * 4 + 0) * 64 + l] + ssqT[(gg * 4 + 1) * 64 + l] + ssqT[(gg * 4 + 2) * 64 + l] + ssqT[(gg * 4 + 3) * 64 + l];
            const float rstd = 1.f / sqrtf(tot * (1.f / 256.f) + NORM_EPS);
#pragma unroll
            for (int pb = 0; pb < 4; ++pb) { const f32x4 t4 = (f32x4){__uint_as_float(yk[lb][pb].x << 16), __uint_as_float(yk[lb][pb].x & 0xffff0000u), __uint_as_float(yk[lb][pb].y << 16), __uint_as_float(yk[lb][pb].y & 0xffff0000u)} * rstd; *(unsigned*)(ymix8 + (size_t)(m0 + l) * 1024 + h * 64 + 4 * fq + 16 * pb) = pk4_fp8(clamp_fp8(t4[0]), clamp_fp8(t4[1]), clamp_fp8(t4[2]), clamp_fp8(t4[3])); } }
        __syncthreads();
    }
}

constexpr int ATT_KB = 12288, ATT_VB = 8192, ATT_NB = 4, ATT_V0 = ATT_NB * ATT_KB;
constexpr float ATT_THR = 8.f;
constexpr int ATT_NQ = 4;
struct SideW { int first, stride, issued, consumed, hist; };
constexpr int SIDE_NITEMS = 32 * 16 * 32;
__device__ __forceinline__ LAS unsigned char* side_ring(LAS unsigned char* lds, int wid) { return lds + 81920 + wid * 4096; }
__device__ __forceinline__ LAS unsigned* side_stg(LAS unsigned char* lds, int wid) { return (LAS unsigned*)(lds + (wid < 4 ? 114688 + wid * 4352 : 141312 + (wid - 4) * 4352)); }
__device__ __forceinline__ bool side_issue(SideW& s, const float* wsrc, LAS unsigned char* lds, int wid, int lane) {
    asm volatile("" : "+v"(lane));
    const int it = s.first + (s.issued >> 4) * s.stride, p = s.issued & 15;
    if (it >= SIDE_NITEMS) return false;
    const int kb = it & 15, nb = (it >> 4) & 31, e = it >> 9;
    const float* src = wsrc + (size_t)e * 1024 * 2048 + (size_t)(kb * 64 + 4 * p + (lane >> 4)) * 2048 + nb * 64 + 4 * (lane & 15);
    __builtin_amdgcn_global_load_lds((const unsigned*)src, (LAS unsigned*)(side_ring(lds, wid) + (s.issued & 3) * 1024), 16, 0, 0);
    s.issued += 1; return true;
}
__device__ __forceinline__ void side_burst(int it, unsigned char* wdst, LAS unsigned char* lds, int wid, int lane) {
    asm volatile("" : "+v"(lane));
    const LAS unsigned* stg = side_stg(lds, wid);
    const int kb = it & 15, nb = (it >> 4) & 31, e = it >> 9, j0 = (nb & 15) * 64, ndst = (j0 >> 7) * 256 + (j0 & 127) + ((nb >> 4) ? 128 : 0), rr = lane >> 2, c = lane & 3;
#pragma unroll
    for (int jj = 0; jj < 4; ++jj) { const int n = rr + 16 * jj; u32x4 o; o.x = stg[n * 17 + 4 * c]; o.y = stg[n * 17 + 4 * c + 1]; o.z = stg[n * 17 + 4 * c + 2]; o.w = stg[n * 17 + 4 * c + 3];
        *(u32x4*)(wdst + (size_t)e * 2048 * 1024 + (size_t)(ndst + n) * 1024 + kb * 64 + 16 * c) = o; }
}
__device__ __forceinline__ void side_consume(SideW& s, unsigned char* wdst, LAS unsigned char* lds, int wid, int lane) {
    asm volatile("" : "+v"(lane));
    const int p = s.consumed & 15; const LAS float* r = (const LAS float*)(side_ring(lds, wid) + (s.consumed & 3) * 1024) + lane;
    const float f0 = r[0], f1 = r[64], f2 = r[128], f3 = r[192];
    side_stg(lds, wid)[lane * 17 + p] = pk4_fp8(clamp_fp8(f0 * W8_SCALE), clamp_fp8(f1 * W8_SCALE), clamp_fp8(f2 * W8_SCALE), clamp_fp8(f3 * W8_SCALE));
    s.consumed += 1;
    if (p == 15) side_burst(s.first + ((s.consumed - 1) >> 4) * s.stride, wdst, lds, wid, lane);
}
__device__ __forceinline__ int side_step(SideW& s, const float* wsrc, unsigned char* wdst, LAS unsigned char* lds, int wid, int lane) {
    if (s.hist & 4) side_consume(s, wdst, lds, wid, lane);
    const int now = side_issue(s, wsrc, lds, wid, lane) ? 1 : 0;
    s.hist = ((s.hist << 1) | now) & 7; return now;
}
#define VM_WAIT(n_) do { switch (n_) { case 0: asm volatile("s_waitcnt vmcnt(0)" ::: "memory"); break; case 1: asm volatile("s_waitcnt vmcnt(1)" ::: "memory"); break; case 2: asm volatile("s_waitcnt vmcnt(2)" ::: "memory"); break; \
        case 3: asm volatile("s_waitcnt vmcnt(3)" ::: "memory"); break; case 4: asm volatile("s_waitcnt vmcnt(4)" ::: "memory"); break; case 5: asm volatile("s_waitcnt vmcnt(5)" ::: "memory"); break; \
        case 6: asm volatile("s_waitcnt vmcnt(6)" ::: "memory"); break; case 7: asm volatile("s_waitcnt vmcnt(7)" ::: "memory"); break; default: asm volatile("s_waitcnt vmcnt(8)" ::: "memory"); break; } } while (0)
__device__ __forceinline__ void attn_unit(LAS unsigned char* lds, int b, int h, int qb, const bf16_t* q, const bf16_t* kk, const bf16_t* kr, const bf16_t* vt, bf16_t* ymix, SideW& sw, const float* wsrc, unsigned char* wdst) {
    const int tid = threadIdx.x, lane = tid & 63, wid = __builtin_amdgcn_readfirstlane(tid >> 6), fr = lane & 15, fq = lane >> 4;
    const int NT = 8 * qb + 8;
    int key[4] = {wid * 4, (7 - wid) * 4 + 1, ((wid + 4) & 7) * 4 + 2, (7 - ((wid + 4) & 7)) * 4 + 3};
#define ATT_CSWAP(i_, j_) do { const int lo_ = key[i_] < key[j_] ? key[i_] : key[j_], hi_ = key[i_] < key[j_] ? key[j_] : key[i_]; key[i_] = hi_; key[j_] = lo_; } while (0)
    ATT_CSWAP(0, 1); ATT_CSWAP(2, 3); ATT_CSWAP(0, 2); ATT_CSWAP(1, 3); ATT_CSWAP(1, 2);
#undef ATT_CSWAP
    int lastq[ATT_NQ]; unsigned rowq[ATT_NQ];
#pragma unroll
    for (int qk = 0; qk < ATT_NQ; ++qk) { const int ch = __builtin_amdgcn_readfirstlane(key[qk] >> 2), role = __builtin_amdgcn_readfirstlane(key[qk] & 3);
        lastq[qk] = 8 * qb + ch; rowq[qk] = (unsigned)(b * SEQ + qb * 512 + ch * 64 + role * 16); }
    bf16x8 qf[ATT_NQ][3];
#pragma unroll
    for (int qk = 0; qk < ATT_NQ; ++qk) { const bf16_t* qr = q + (size_t)(rowq[qk] + fr) * 768;
        qf[qk][0] = *(const bf16x8*)(qr + h * 64 + fq * 8); qf[qk][1] = *(const bf16x8*)(qr + h * 64 + 32 + fq * 8); qf[qk][2] = *(const bf16x8*)(qr + 512 + h * 32 + fq * 8); }
    const int sb = lane * 16, swz = sb ^ (((sb >> 9) & 1) << 5), rr = swz >> 6, cc = (swz & 63) >> 1;
    const int foff = (fr * 64 + fq * 16) ^ ((((fr * 64 + fq * 16) >> 9) & 1) << 5);
    const int i0 = wid, i1 = 8 + (wid & 3);
    const int p0 = ((i0 % 3) == 2) ? 32 : 512, p1 = ((i1 % 3) == 2) ? 32 : 512;
    const bf16_t* ksrc0 = ((i0 % 3) == 2) ? kr + ((size_t)(b * SEQ + (i0 / 3) * 16 + rr) * 32 + cc) : kk + ((size_t)(b * SEQ + (i0 / 3) * 16 + rr) * 512 + h * 64 + (i0 % 3) * 32 + cc);
    const bf16_t* ksrc1 = ((i1 % 3) == 2) ? kr + ((size_t)(b * SEQ + (i1 / 3) * 16 + rr) * 32 + cc) : kk + ((size_t)(b * SEQ + (i1 / 3) * 16 + rr) * 512 + h * 64 + (i1 % 3) * 32 + cc);
    const bf16_t* vsrc = vt + ((size_t)((b * 8 + h) * 64) * 4096 + ((wid >> 1) * 16 + rr) * 64 + (wid & 1) * 32 + cc);
#define ATT_DMA(t, buf) do { \
        __builtin_amdgcn_global_load_lds((const unsigned*)(ksrc0 + (size_t)(t) * 64 * p0), (LAS unsigned*)(lds + (buf) * ATT_KB + i0 * 1024), 16, 0, 0); \
        if (wid < 4) __builtin_amdgcn_global_load_lds((const unsigned*)(ksrc1 + (size_t)(t) * 64 * p1), (LAS unsigned*)(lds + (buf) * ATT_KB + i1 * 1024), 16, 0, 0); \
        __builtin_amdgcn_global_load_lds((const unsigned*)(vsrc + (size_t)(t) * 4096), (LAS unsigned*)(lds + ATT_V0 + (buf) * ATT_VB + wid * 1024), 16, 0, 0); } while (0)
    f32x4 O[4][ATT_NQ], L[ATT_NQ];
#pragma unroll
    for (int qk = 0; qk < ATT_NQ; ++qk) { L[qk] = (f32x4){0.f, 0.f, 0.f, 0.f};
#pragma unroll
        for (int d = 0; d < 4; ++d) O[d][qk] = (f32x4){0.f, 0.f, 0.f, 0.f}; }
    float mrun[ATT_NQ], lchk[ATT_NQ];
#pragma unroll
    for (int qk = 0; qk < ATT_NQ; ++qk) { mrun[qk] = 0.f; lchk[qk] = 1.f; }
    const bf16x8 ones = {0x3F80, 0x3F80, 0x3F80, 0x3F80, 0x3F80, 0x3F80, 0x3F80, 0x3F80};
#define ATT_TILE(NA_) do { \
            const LAS unsigned char* kb = lds + (t & 3) * ATT_KB + foff; const LAS unsigned char* vb = lds + ATT_V0 + (t & 3) * ATT_VB + foff; \
              \
            _Pragma("unroll") for (int qk = 0; qk < NA_; ++qk) { const float lv = lchk[qk]; \
                if (__any(lv > 0x1p40f || (t > 1 && lv < 0x1p-40f))) { \
                    const bool need = lv > 0x1p40f || (t > 1 && lv < 0x1p-40f); \
                    const float d = need ? (lv < 0x1p-120f ? -100.f : floorf(__builtin_amdgcn_logf(lv))) : 0.f, sc = __builtin_amdgcn_exp2f(-d); \
                    mrun[qk] += d; L[qk] = L[qk] * sc; \
                    _Pragma("unroll") for (int dd = 0; dd < 4; ++dd) O[dd][qk] = O[dd][qk] * sc; } } \
            f32x4 S[4][NA_]; \
            _Pragma("unroll") for (int kv = 0; kv < 4; ++kv) \
                _Pragma("unroll") for (int qk = 0; qk < NA_; ++qk) { const float nm = -mrun[qk]; S[kv][qk] = (f32x4){nm, nm, nm, nm}; } \
            _Pragma("unroll") for (int st = 0; st < 3; ++st) \
                _Pragma("unroll") for (int kv = 0; kv < 4; ++kv) { const bf16x8 a = *(const LAS bf16x8*)(kb + (kv * 3 + st) * 1024); \
                    _Pragma("unroll") for (int qk = 0; qk < NA_; ++qk) S[kv][qk] = __builtin_amdgcn_mfma_f32_16x16x32_bf16(a, qf[qk][st], S[kv][qk], 0, 0, 0); } \
            bf16x8 pf[NA_][2]; \
            _Pragma("unroll") for (int qk = 0; qk < NA_; ++qk) { \
                _Pragma("unroll") for (int kv = 0; kv < 4; ++kv) \
                    _Pragma("unroll") for (int i = 0; i < 4; ++i) S[kv][qk][i] = __builtin_amdgcn_exp2f(S[kv][qk][i]); \
                _Pragma("unroll") for (int s2 = 0; s2 < 2; ++s2) { u32x4 w; w.x = pk2(S[2 * s2][qk][0], S[2 * s2][qk][1]); w.y = pk2(S[2 * s2][qk][2], S[2 * s2][qk][3]); w.z = pk2(S[2 * s2 + 1][qk][0], S[2 * s2 + 1][qk][1]); w.w = pk2(S[2 * s2 + 1][qk][2], S[2 * s2 + 1][qk][3]); \
                    pf[qk][s2] = __builtin_bit_cast(bf16x8, w); } } \
            _Pragma("unroll") for (int qk = 0; qk < NA_; ++qk) lchk[qk] = L[qk][0]; \
            _Pragma("unroll") for (int s2 = 0; s2 < 2; ++s2) { \
                _Pragma("unroll") for (int d = 0; d < 4; ++d) { const bf16x8 a = *(const LAS bf16x8*)(vb + (d * 2 + s2) * 1024); \
                    _Pragma("unroll") for (int qk = 0; qk < NA_; ++qk) O[d][qk] = __builtin_amdgcn_mfma_f32_16x16x32_bf16(a, pf[qk][s2], O[d][qk], 0, 0, 0); } \
                _Pragma("unroll") for (int qk = 0; qk < NA_; ++qk) L[qk] = __builtin_amdgcn_mfma_f32_16x16x32_bf16(ones, pf[qk][s2], L[qk], 0, 0, 0); } } while (0)
    ATT_DMA(0, 0); ATT_DMA(1, 1); ATT_DMA(2, 2);
#define ATT_SYNC() do { VM_WAIT(c1 + c2); \
        __builtin_amdgcn_s_barrier(); asm volatile("" ::: "memory"); \
        int now_ = 0; if (t + 3 < NT) { ATT_DMA(t + 3, (t + 3) & 3); now_ = PW; } \
        c2 = c1; c1 = now_; } while (0)
#define ATT_SIDE() do { c1 += side_step(sw, wsrc, wdst, lds, wid, lane); } while (0)
    const int PW = (wid < 4) ? 3 : 2;
#pragma unroll
    for (int qk = 0; qk < ATT_NQ; ++qk) asm volatile("" : "+v"(qf[qk][0]), "+v"(qf[qk][1]), "+v"(qf[qk][2]));
    int c1 = PW, c2 = PW;
    int t = 0;
    for (; t <= lastq[3]; ++t) { ATT_SYNC(); ATT_TILE(4); ATT_SIDE(); }
    for (; t <= lastq[2]; ++t) { ATT_SYNC(); ATT_TILE(3); ATT_SIDE(); }
    for (; t <= lastq[1]; ++t) { ATT_SYNC(); ATT_TILE(2); ATT_SIDE(); }
    for (; t <= lastq[0]; ++t) { ATT_SYNC(); ATT_TILE(1); ATT_SIDE(); }
    for (; t < NT; ++t) { ATT_SYNC(); ATT_SIDE(); }
#undef ATT_SYNC
#undef ATT_SIDE
#undef ATT_TILE
#undef ATT_DMA
#pragma unroll
    for (int qk = 0; qk < ATT_NQ; ++qk) { const float il = 1.f / L[qk][0];
        bf16_t* op = ymix + (size_t)(rowq[qk] + fr) * 1024 + 512 + h * 64 + 4 * fq;
#pragma unroll
        for (int d = 0; d < 4; ++d) st_bf16x4(op + d * 16, O[d][qk] * il); }
    asm volatile("s_waitcnt lgkmcnt(0)" ::: "memory"); __builtin_amdgcn_s_barrier(); asm volatile("" ::: "memory");
}
__device__ __forceinline__ void attn_mfma(const Frame& F, const Args& args) {
    unsigned char* ws = args.ws; const bf16_t* q = (const bf16_t*)(ws + WS_Q); const bf16_t* kk = (const bf16_t*)(ws + WS_KK); const bf16_t* kr = (const bf16_t*)(ws + WS_KR); const bf16_t* vt = (const bf16_t*)(ws + WS_V); bf16_t* ymix = (bf16_t*)(ws + WS_YMIX);
    SideW sw; sw.first = F.bid * NWAVES + F.wave; sw.stride = F.G * NWAVES; sw.issued = 0; sw.consumed = 0; sw.hist = 0;
    const float* wsrc = IN_F(23); unsigned char* wdst = ws + WS_WGU_T;
    for (int c = F.vcu; c < 512; c += F.G) { const int bh = c >> 2, pr = c & 3;
        attn_unit(F.lds, bh >> 3, bh & 7, pr, q, kk, kr, vt, ymix, sw, wsrc, wdst); attn_unit(F.lds, bh >> 3, bh & 7, 7 - pr, q, kk, kr, vt, ymix, sw, wsrc, wdst); }
    asm volatile("s_waitcnt vmcnt(0)" ::: "memory");
    while (sw.consumed < sw.issued) side_consume(sw, wdst, F.lds, F.wave, F.lane);
    while ((sw.issued & 15) != 0) { int n = 0;
        while (n < 4 && (sw.issued & 15) != 0) { side_issue(sw, wsrc, F.lds, F.wave, F.lane); ++n; }
        asm volatile("s_waitcnt vmcnt(0)" ::: "memory");
        while (sw.consumed < sw.issued) side_consume(sw, wdst, F.lds, F.wave, F.lane); }
    asm volatile("s_waitcnt lgkmcnt(0)" ::: "memory");
    for (int it = sw.first + (sw.issued >> 4) * sw.stride; it < SIDE_NITEMS; it += sw.stride) { const int kb = it & 15, nb = (it >> 4) & 31, e = it >> 9; const int j0 = (nb & 15) * 64;
        tr8_item(IN_F(23) + (size_t)e * 1024 * 2048, 2048, 1024, ws + WS_WGU_T + (size_t)e * 2048 * 1024, nb * 64, (j0 >> 7) * 256 + (j0 & 127) + ((nb >> 4) ? 128 : 0), kb * 64, side_stg(F.lds, F.wave), F.lane); }
}

__device__ __forceinline__ void ph7_mixpost(const Frame& F, const Args& args) {
    const bf16_t* ymix = (const bf16_t*)(args.ws + WS_YMIX); unsigned char* ymix8 = args.ws + WS_YMIX8;
    for (int q = 0; ; ++q) { const int pm_ = F.vcu + (q >> 2) * F.G; if (pm_ >= NTOK / 256) break; const int m0 = 256 * pm_ + (q & 3) * 64 + F.wave * 8;
        u32x4 v[8]; float ss[8];
#pragma unroll
        for (int r = 0; r < 8; ++r) v[r] = *(const u32x4*)(ymix + (size_t)(m0 + r) * 1024 + 512 + 8 * F.lane);
#pragma unroll
        for (int r = 0; r < 8; ++r) { const f32x4 a = bf_lo4(v[r]), b2 = bf_hi4(v[r]); ss[r] = a[0] * a[0] + a[1] * a[1] + a[2] * a[2] + a[3] * a[3] + b2[0] * b2[0] + b2[1] * b2[1] + b2[2] * b2[2] + b2[3] * b2[3]; }
#pragma unroll
        for (int o = 1; o < 64; o <<= 1) {
#pragma unroll
            for (int r = 0; r < 8; ++r) ss[r] += __shfl_xor(ss[r], o); }
#pragma unroll
        for (int r = 0; r < 8; ++r) { const float rstd = 1.f / sqrtf(ss[r] * (1.f / 512.f) + NORM_EPS); const f32x4 a = bf_lo4(v[r]) * rstd, b2 = bf_hi4(v[r]) * rstd;
            u32x2 o; o.x = pk4_fp8(clamp_fp8(a[0]), clamp_fp8(a[1]), clamp_fp8(a[2]), clamp_fp8(a[3])); o.y = pk4_fp8(clamp_fp8(b2[0]), clamp_fp8(b2[1]), clamp_fp8(b2[2]), clamp_fp8(b2[3]));
            *(u32x2*)(ymix8 + (size_t)(m0 + r) * 1024 + 512 + 8 * F.lane) = o; }
    }
}

__device__ __forceinline__ void ph9_rowpass(const Frame& F, const Args& args) {
    unsigned char* ws = args.ws; const float* x = IN_F(0); const bf16_t* mix = (const bf16_t*)(ws + WS_MIX); const float* mod = (const float*)(ws + WS_MOD);
    const float* g_post = IN_F(19); const float* g_pre = IN_F(20); unsigned char* h2q = ws + WS_H2Q; bf16_t* x1b = (bf16_t*)(ws + WS_X1B);
    float* logits = (float*)(ws + WS_LOGITS); const float* rbias = IN_F(22);
    { const bf16_t* wrt = (const bf16_t*)(ws + WS_WR_T);
      for (int ch = F.tid; ch < 4096; ch += NTHR) { const int r = ch >> 7, c8 = (ch & 127) * 8;
          *(LAS u32x4*)(F.lds + (c8 >> 6) * 4096 + pg8::lds_byte(r, c8 & 63)) = *(const u32x4*)(wrt + (size_t)r * 1024 + c8); }
      __syncthreads(); }
    constexpr int R9 = 4;
    LAS unsigned char* hb = F.lds + 65536 + F.wave * 8704;
    const int fr = F.lane & 15, fq = F.lane >> 4;
    const int foff = (fr * 64 + fq * 16) ^ ((((fr * 64 + fq * 16) >> 9) & 1) << 5);
    const f32x4 rb0 = *(const f32x4*)(rbias + 4 * fq), rb1 = *(const f32x4*)(rbias + 16 + 4 * fq);
    for (int q = 0; ; ++q) { const int pm_ = F.vcu + (q >> 3) * F.G; if (pm_ >= NTOK / 256) break; const int m0 = 256 * pm_ + (q & 7) * (NWAVES * R9) + F.wave * R9;
        const int b = m0 >> 12; const float* mb = mod + b * 6144; f32x4 mv[R9][4], xv[R9][4]; float ss[R9], ss2[R9];
#pragma unroll
        for (int r = 0; r < R9; ++r)
#pragma unroll
            for (int j = 0; j < 4; ++j) { { const u32x2 w2 = __builtin_nontemporal_load((const u32x2*)(mix + (size_t)(m0 + r) * DM + 4 * F.lane + 256 * j)); mv[r][j] = (f32x4){__uint_as_float(w2.x << 16), __uint_as_float(w2.x & 0xffff0000u), __uint_as_float(w2.y << 16), __uint_as_float(w2.y & 0xffff0000u)}; } xv[r][j] = __builtin_nontemporal_load((const f32x4*)(x + (size_t)(m0 + r) * DM + 4 * F.lane + 256 * j)); }
#pragma unroll
        for (int r = 0; r < R9; ++r) { float t = 0.f;
#pragma unroll
            for (int j = 0; j < 4; ++j) t += mv[r][j][0] * mv[r][j][0] + mv[r][j][1] * mv[r][j][1] + mv[r][j][2] * mv[r][j][2] + mv[r][j][3] * mv[r][j][3];
            ss[r] = t; }
#pragma unroll
        for (int o = 1; o < 64; o <<= 1) {
#pragma unroll
            for (int r = 0; r < R9; ++r) ss[r] += __shfl_xor(ss[r], o); }
#pragma unroll
        for (int r = 0; r < R9; ++r) { const float rstd = 1.f / sqrtf(ss[r] * (1.f / DM) + NORM_EPS); float t = 0.f;
#pragma unroll
            for (int j = 0; j < 4; ++j) { const int col = 4 * F.lane + 256 * j; xv[r][j] = xv[r][j] + *(const f32x4*)(mb + 2048 + col) * (mv[r][j] * rstd * *(const f32x4*)(g_post + col));
                { u32x2 w2; w2.x = pk2(xv[r][j][0], xv[r][j][1]); w2.y = pk2(xv[r][j][2], xv[r][j][3]); __builtin_nontemporal_store(w2, (u32x2*)(x1b + (size_t)(m0 + r) * DM + col)); } t += xv[r][j][0] * xv[r][j][0] + xv[r][j][1] * xv[r][j][1] + xv[r][j][2] * xv[r][j][2] + xv[r][j][3] * xv[r][j][3]; }
            ss2[r] = t; }
#pragma unroll
        for (int o = 1; o < 64; o <<= 1) {
#pragma unroll
            for (int r = 0; r < R9; ++r) ss2[r] += __shfl_xor(ss2[r], o); }
#pragma unroll
        for (int r = 0; r < R9; ++r) { const float rstd2 = 1.f / sqrtf(ss2[r] * (1.f / DM) + NORM_EPS);
#pragma unroll
            for (int j = 0; j < 4; ++j) { const int col = 4 * F.lane + 256 * j;
                const f32x4 hv = xv[r][j] * rstd2 * *(const f32x4*)(g_pre + col) * (*(const f32x4*)(mb + 4096 + col) + 1.f) + *(const f32x4*)(mb + 3072 + col);
                { u32x2 w2; w2.x = pk2(hv[0], hv[1]); w2.y = pk2(hv[2], hv[3]); *(LAS u32x2*)(hb + r * 2112 + col * 2) = w2; }
                *(unsigned*)(h2q + (size_t)(m0 + r) * DM + col) = pk4_fp8(clamp_fp8(hv[0]), clamp_fp8(hv[1]), clamp_fp8(hv[2]), clamp_fp8(hv[3])); } }
        f32x4 ra[2][2];
#pragma unroll
        for (int e = 0; e < 2; ++e) { ra[e][0] = (f32x4){0.f, 0.f, 0.f, 0.f}; ra[e][1] = ra[e][0]; }
        const LAS unsigned char* hrow = hb + (fr & (R9 - 1)) * 2112 + fq * 16;
#pragma unroll 4
        for (int kt = 0; kt < 16; ++kt) {
#pragma unroll
            for (int kh = 0; kh < 2; ++kh) { const bf16x8 hf = *(const LAS bf16x8*)(hrow + kt * 128 + kh * 64);
#pragma unroll
                for (int e = 0; e < 2; ++e) { const bf16x8 wf = *(const LAS bf16x8*)(F.lds + kt * 4096 + (e * 2 + kh) * 1024 + foff);
                    ra[e][kh] = __builtin_amdgcn_mfma_f32_16x16x32_bf16(wf, hf, ra[e][kh], 0, 0, 0); } } }
        if (fr < R9) { float* lp = logits + (size_t)(m0 + fr) * 32 + 4 * fq;
            *(f32x4*)lp = ra[0][0] + ra[0][1] + rb0; *(f32x4*)(lp + 16) = ra[1][0] + ra[1][1] + rb1; }
    }
    __syncthreads();
}

__device__ __forceinline__ void ph11_topk(const Frame& F, const Args& args) {
    unsigned char* ws = args.ws; const float* logits = (const float*)(ws + WS_LOGITS); unsigned* cnt = (unsigned*)(ws + WS_CTL) + CW_CNT;
    int* tope = (int*)(ws + WS_TOPE); float* topg = (float*)(ws + WS_TOPG); int* topr = (int*)(ws + WS_TOPR);
    int* slot_tok = (int*)(ws + WS_SLOT_TOK); int* slot_y = (int*)(ws + WS_SLOT_Y); float* slot_g = (float*)(ws + WS_SLOT_G);
    for (int i = gtid(F); i < NSLOT; i += F.G * NTHR) { slot_tok[i] = 0; slot_y[i] = -1; slot_g[i] = 0.f; }
    LAS unsigned* hist = (LAS unsigned*)F.lds; LAS unsigned* base = hist + 32;
    for (int pm_ = F.vcu; pm_ < NTOK / 256; pm_ += F.G) { const bool act = F.tid < 256;
        if (F.tid < 32) hist[F.tid] = 0u;
        __syncthreads();
        const int tok = 256 * pm_ + (F.tid & 255); float lv[32];
#pragma unroll
        for (int j = 0; j < 8; ++j) { const f32x4 t = *(const f32x4*)(logits + (size_t)tok * 32 + 4 * j); lv[4 * j] = t[0]; lv[4 * j + 1] = t[1]; lv[4 * j + 2] = t[2]; lv[4 * j + 3] = t[3]; }
        int ei[4]; float ev[4];
#pragma unroll
        for (int k = 0; k < 4; ++k) { float best = -INFINITY; int bi = 0;
#pragma unroll
            for (int e = 0; e < 32; ++e) { if (lv[e] > best) { best = lv[e]; bi = e; } }
            ei[k] = bi; ev[k] = best;
#pragma unroll
            for (int e = 0; e < 32; ++e) { if (e == bi) lv[e] = -INFINITY; } }
        float gs = 0.f, gv[4];
#pragma unroll
        for (int k = 0; k < 4; ++k) { gv[k] = __expf(ev[k] - ev[0]); gs += gv[k]; }
        int lr[4];
#pragma unroll
        for (int k = 0; k < 4; ++k) lr[k] = act ? (int)atomicAdd((unsigned*)&hist[ei[k]], 1u) : 0;
        __syncthreads();
        if (F.tid < 32) base[F.tid] = atomicAdd(&cnt[F.tid], (unsigned)hist[F.tid]);
        __syncthreads();
        if (act) {
#pragma unroll
        for (int k = 0; k < 4; ++k) { tope[(size_t)tok * 4 + k] = ei[k]; topg[(size_t)tok * 4 + k] = gv[k] / gs; topr[(size_t)tok * 4 + k] = (int)base[ei[k]] + lr[k]; } }
        __syncthreads();
    }
}
__device__ __forceinline__ void moe_tables(const Frame& F, const Args& args, LAS int* pstart, LAS int* pend) {
    const unsigned* cnt = (const unsigned*)(args.ws + WS_CTL) + CW_CNT;
    if (F.tid < 64) {
        const int e = F.tid & 31; const int c = (int)__hip_atomic_load(cnt + e, __ATOMIC_RELAXED, __HIP_MEMORY_SCOPE_AGENT);
        const int padded = ((c + 255) / 256) * 256; int run = padded;
#pragma unroll
        for (int off = 1; off < 32; off <<= 1) { const int t = __shfl_up(run, off); if ((F.tid & 31) >= off) run += t; }
        if (F.tid < 32) { pstart[e] = run - padded; pend[e] = run; }
    }
    __syncthreads();
    const int npanel = pend[NEXP - 1] / 256;
    for (int p = F.tid; p < npanel; p += NTHR) { int e = 0; while (e < NEXP - 1 && pend[e] <= p * 256) ++e; pend[32 + p] = e; }
    __syncthreads();
}
__device__ __forceinline__ void ph12_slots(const Frame& F, const Args& args) {
    unsigned char* ws = args.ws; LAS int* pstart = (LAS int*)(F.lds + MISC_OFF + 64); LAS int* pend = pstart + 32;
    moe_tables(F, args, pstart, pend);
    const int* tope = (const int*)(ws + WS_TOPE); const float* topg = (const float*)(ws + WS_TOPG); const int* topr = (const int*)(ws + WS_TOPR);
    int* slot_tok = (int*)(ws + WS_SLOT_TOK); int* slot_y = (int*)(ws + WS_SLOT_Y); float* slot_g = (float*)(ws + WS_SLOT_G);
    for (int i = gtid(F); i < NTOK * 4; i += F.G * NTHR) { const int dest = pstart[tope[i]] + topr[i]; slot_tok[dest] = i >> 2; slot_y[dest] = i; slot_g[dest] = topg[i]; }
}

__device__ __forceinline__ void ph14_final(const Frame& F, const Args& args) {
    unsigned char* ws = args.ws; const unsigned char* y4 = ws + WS_Y4; const bf16_t* x1b = (const bf16_t*)(ws + WS_X1B); const float* mod = (const float*)(ws + WS_MOD); const float* gain = IN_F(27); float* out = args.out;
    for (int m0 = (F.bid * NWAVES + F.wave) * 2; m0 < NTOK; m0 += F.G * NWAVES * 2) {
        const int b = m0 >> 12; f32x4 f[2][4], xo[2][4]; float ss[2];
#pragma unroll
        for (int r = 0; r < 2; ++r)
#pragma unroll
            for (int j = 0; j < 4; ++j) { const int col = 4 * F.lane + 256 * j; const unsigned char* yp = y4 + ((size_t)(m0 + r) * 4) * DM + col;
                f[r][j] = (ld_fp8x4(yp) + ld_fp8x4(yp + DM)) + (ld_fp8x4(yp + 2 * DM) + ld_fp8x4(yp + 3 * DM)); { const u32x2 w2 = __builtin_nontemporal_load((const u32x2*)(x1b + (size_t)(m0 + r) * DM + col)); xo[r][j] = (f32x4){__uint_as_float(w2.x << 16), __uint_as_float(w2.x & 0xffff0000u), __uint_as_float(w2.y << 16), __uint_as_float(w2.y & 0xffff0000u)}; } }
#pragma unroll
        for (int r = 0; r < 2; ++r) { float t = 0.f;
#pragma unroll
            for (int j = 0; j < 4; ++j) t += f[r][j][0] * f[r][j][0] + f[r][j][1] * f[r][j][1] + f[r][j][2] * f[r][j][2] + f[r][j][3] * f[r][j][3];
            ss[r] = t; }
#pragma unroll
        for (int o = 1; o < 64; o <<= 1) { ss[0] += __shfl_xor(ss[0], o); ss[1] += __shfl_xor(ss[1], o); }
#pragma unroll
        for (int r = 0; r < 2; ++r) { const float rstd = 1.f / sqrtf(ss[r] * (1.f / DM) + NORM_EPS);
#pragma unroll
            for (int j = 0; j < 4; ++j) { const int col = 4 * F.lane + 256 * j;
                __builtin_nontemporal_store(xo[r][j] + *(const f32x4*)(mod + b * 6144 + 5120 + col) * (f[r][j] * rstd * *(const f32x4*)(gain + col)), (f32x4*)(out + (size_t)(m0 + r) * DM + col)); } }
    }
}

typedef const __attribute__((address_space(4))) unsigned long long* karg_p;
__device__ __forceinline__ void load_args(Args& a) {
    karg_p kp = (karg_p)__builtin_amdgcn_kernarg_segment_ptr();
    asm volatile("" : "+s"(kp));
#pragma unroll
    for (int i = 0; i < 28; ++i) a.in[i] = (const void*)(GAS const void*)kp[i];
    a.out = (float*)(GAS float*)kp[28]; a.ws = (unsigned char*)(GAS unsigned char*)kp[29]; a.ph_lo = 0; a.ph_hi = 0; a.li = 0; a.pad = 0;
}
#define PH_BEGIN Args args; load_args(args); unsigned char* ws = args.ws; (void)ws
constexpr int N_PHASES = 15;
__global__ void __launch_bounds__(NTHR, 2) fwd(Args kargs) {
    extern __shared__ __attribute__((aligned(16))) unsigned char lds_raw[];
    Frame F; F.lds = (LAS unsigned char*)lds_raw; F.tid = threadIdx.x; F.lane = F.tid & 63; F.wave = __builtin_amdgcn_readfirstlane(F.tid >> 6); F.G = gridDim.x; F.bid = blockIdx.x; F.a = nullptr; F.vcu = (F.G % 8 == 0) ? (F.bid % 8) * (F.G / 8) + F.bid / 8 : F.bid;
    volatile LAS unsigned* MISC = (volatile LAS unsigned*)(F.lds + MISC_OFF);
    if (F.tid < 16) MISC[F.tid] = 0u;
    __syncthreads();
    XcdBarrier bar = xcd_barrier_post((unsigned*)(kargs.ws + WS_CTL) + CW_BAR + kargs.li * XCD_BAR_WORDS, MISC);
    const int lo = kargs.ph_lo, hi = kargs.ph_hi;
#ifndef PHASE_MASK
#define PHASE_MASK 0xffffffffu
#endif
#define IN(k) (((PHASE_MASK >> (k)) & 1u) && lo <= (k) && (k) < hi)
#ifndef REPEAT_MASK
#define REPEAT_MASK 0u
#endif
#define REP(k) for (int rep_ = 0; rep_ < ((((REPEAT_MASK) >> (k)) & 1u) ? 2 : 1); ++rep_)
#define SEAM(k) do { if (IN(k) && IN((k) + 1)) xcd_barrier(bar); } while (0)

    if (IN(0)) REP(0) { PH_BEGIN; ph0_prep(F, args); } SEAM(0);
    if (IN(1)) REP(1) { PH_BEGIN; ph1_h1(F, args); } SEAM(1);
    if (IN(2)) REP(2) { PH_BEGIN;
        Gemm g{(const bf16_t*)(ws + WS_H1), 1024, (const bf16_t*)(ws + WS_WIN_T), 1024, nullptr}; DenseOrder S; S.init(NTOK, PROJ_LD, F.G, F.vcu);
        EpiStoreBf16S E{(bf16_t*)(ws + WS_PROJ), PROJ_LD, W8_INV}; GEMM_PHASE_F8(F.lds, g, S, E);
    } SEAM(2);
    if (IN(3)) REP(3) { PH_BEGIN; ph3_tokprep(F, args); } SEAM(3);
    if (IN(4)) REP(4) { PH_BEGIN;
        { Gemm g{(const bf16_t*)(ws + WS_PROJ) + PC_QA, PROJ_LD, (const bf16_t*)(ws + WS_WQ_T), 384, nullptr}; DenseOrder S; S.init(NTOK, 768, F.G, F.vcu);
          EpiQ E{(bf16_t*)(ws + WS_Q), (const float*)(ws + WS_RSTDQ), (const float*)(ws + WS_COS), (const float*)(ws + WS_SIN), F.lds}; GEMM_PHASE(F.lds, g, S, E); }
        { Gemm g{(const bf16_t*)(ws + WS_PROJ) + PC_KVA, PROJ_LD, (const bf16_t*)(ws + WS_WKV_T), 256, nullptr}; DenseOrder S; S.init(NTOK, 512, F.G, F.vcu);
          EpiK E{(bf16_t*)(ws + WS_KK), (const float*)(ws + WS_RSTDKV), F.lds}; GEMM_PHASE(F.lds, g, S, E); }
        { Gemm g{(const bf16_t*)(ws + WS_PROJ) + PC_KVA, PROJ_LD, (const bf16_t*)(ws + WS_WKV_T) + 512 * 256, 256, nullptr}; DenseOrder S; S.init(NTOK, 512, F.G, F.vcu);
          EpiVT E{(bf16_t*)(ws + WS_V), (const float*)(ws + WS_RSTDKV), F.lds}; GEMM_PHASE_SWAP(F.lds, g, S, E); }
        ssd_phase_a(F, args);
    } SEAM(4);
    if (IN(5)) REP(5) { PH_BEGIN; ssd_phase_b(F, args); attn_mfma(F, args); } SEAM(5);
    if (IN(6)) REP(6) { PH_BEGIN; ssd_phase_c(F, args); ph7_mixpost(F, args); }
#define LOCAL_SEAM() do { asm volatile("s_waitcnt vmcnt(0)" ::: "memory"); __builtin_amdgcn_fence(__ATOMIC_RELEASE, "workgroup"); __syncthreads(); __builtin_amdgcn_fence(__ATOMIC_ACQUIRE, "workgroup"); } while (0)
    if (IN(6) && IN(8)) xcd_barrier(bar);
    const bool conv_first = ((F.bid >> 3) & 1) != 0;
    if (IN(8)) REP(8) { PH_BEGIN;
        if (conv_first) { ph_moe_weights(F, args); __syncthreads(); }
        Gemm g{(const bf16_t*)(ws + WS_YMIX8), 1024, (const bf16_t*)(ws + WS_WOUT_T), 1024, nullptr}; DenseOrder S; S.init(NTOK, 1024, F.G, F.vcu, 1);
        EpiStoreBf16S E{(bf16_t*)(ws + WS_MIX), 1024, W8_INV}; GEMM_PHASE_F8(F.lds, g, S, E);
    } if (IN(8) && IN(9)) LOCAL_SEAM();
    if (IN(9)) REP(9) { PH_BEGIN; ph9_rowpass(F, args); if (!conv_first) ph_moe_weights(F, args); } if (IN(9) && IN(11)) LOCAL_SEAM();
    if (IN(11)) REP(11) { PH_BEGIN; ph11_topk(F, args); } SEAM(11);
    if (IN(12)) REP(12) { PH_BEGIN; ph12_slots(F, args); } SEAM(12);
    if (IN(13)) REP(13) { PH_BEGIN;
        LAS int* pstart = (LAS int*)(F.lds + MISC_OFF + 64); LAS int* pend = pstart + 32;
        if (!IN(12)) moe_tables(F, args, pstart, pend);
        const int npanel = pend[NEXP - 1] / 256;
        { Gemm g{(const bf16_t*)(ws + WS_H2Q), 1024, (const bf16_t*)(ws + WS_WGU_T), 1024, (const int*)(ws + WS_SLOT_TOK)};
          MoeOrder S{8, npanel * 8, F.G, F.vcu, 0, 0, pend}; EpiGU E{ws + WS_ACT, IN_F(24), 0, F.lds}; GEMM_PHASE_F8G(F.lds, g, S, E); }
        xcd_barrier(bar);
        { Gemm g{(const bf16_t*)(ws + WS_ACT), 1024, (const bf16_t*)(ws + WS_WDN_T), 1024, nullptr};
          MoeOrder S{4, npanel * 4, F.G, F.vcu, 0, 0, pend}; EpiDown E{ws + WS_Y4, IN_F(26), (const int*)(ws + WS_SLOT_Y), (const float*)(ws + WS_SLOT_G), F.lds}; GEMM_PHASE_F8(F.lds, g, S, E); }
        xcd_barrier(bar);
    }
    if (IN(14)) REP(14) { PH_BEGIN; ph14_final(F, args); }
#undef IN
#undef SEAM
}

extern "C" void kernel_launch(void* const* d_in, const int* in_sizes, int n_in, void* d_out, int out_size, void* d_ws, size_t ws_size, hipStream_t stream) {
    static int grid = 0;
    if (grid == 0) {
        if (n_in != 28 || out_size != NTOK * DM || ws_size < WS_END) { fprintf(stderr, "kernel_launch: unexpected shapes n_in %d out %d ws %zu\n", n_in, out_size, ws_size); grid = -1; return; }
        int dev = 0, cus = 0, per_cu = 0;
        if (hipGetDevice(&dev) != hipSuccess || hipDeviceGetAttribute(&cus, hipDeviceAttributeMultiprocessorCount, dev) != hipSuccess) { grid = -1; return; }
        if (hipFuncSetAttribute((const void*)fwd, hipFuncAttributeMaxDynamicSharedMemorySize, LDS_BYTES) != hipSuccess) { fprintf(stderr, "kernel_launch: hipFuncSetAttribute failed\n"); grid = -1; return; }
        if (hipOccupancyMaxActiveBlocksPerMultiprocessor(&per_cu, (const void*)fwd, NTHR, LDS_BYTES) != hipSuccess || per_cu < 1) fprintf(stderr, "kernel_launch: occupancy query says %d\n", per_cu);
        (void)hipGetLastError();
        grid = cus;
    }
    if (grid < 0) return;
    (void)hipMemsetAsync((char*)d_ws + WS_CTL, 0, CTL_ZERO_BYTES, stream);
    Args a{};
    for (int i = 0; i < 28; ++i) a.in[i] = d_in[i];
    a.out = (float*)d_out; a.ws = (unsigned char*)d_ws;
#if N_LAUNCH_MODE == 1
    a.ph_lo = 0; a.ph_hi = N_PHASES; a.li = 0;
    hipLaunchKernelGGL(fwd, dim3(grid), dim3(NTHR), LDS_BYTES, stream, a);
#else
    for (int p = 0; p < N_PHASES; ++p) {
        a.ph_lo = p; a.ph_hi = p + 1; a.li = p;
        hipLaunchKernelGGL(fwd, dim3(grid), dim3(NTHR), LDS_BYTES, stream, a);
    }
#endif
}
```
